# Optimizing an MI355X kernel written in HIP

```python
import jax, jax.numpy as jnp
from jax import lax
import numpy as np

D_MODEL = 1024
BATCH = 2
SEQ = 8192
DEPTH = 1

N_META = 16
CHUNK = 128
PAD = CHUNK - N_META
RET_HEADS = 4
RET_DK = D_MODEL // RET_HEADS
RET_DV = 2 * RET_DK
SB_HEADS = D_MODEL // 64
SB_DH = 64
D_FF = -(-8 * D_MODEL // (3 * 256)) * 256
ROPE_BASE = 10000.0
NORM_EPS = 1e-6
GN_EPS = 1e-5
PROJ_SPLIT = (
    RET_HEADS * RET_DK,
    RET_HEADS * RET_DK,
    RET_HEADS * RET_DV,
    RET_HEADS * RET_DV,
    SB_HEADS * SB_DH,
    SB_HEADS * SB_DH,
    SB_HEADS * SB_DH,
    D_MODEL,
    D_MODEL,
)
PROJ_WIDTH = sum(PROJ_SPLIT)

kernel_name = "hybrid_retention_stickbreaking_block"


def rmsnorm(x, g):
    xf = x.astype(jnp.float32)
    y = xf * lax.rsqrt(jnp.mean(xf * xf, axis=-1, keepdims=True) + NORM_EPS)
    return (y * g.astype(jnp.float32)).astype(x.dtype)


def rotary(x, pos):
    half = x.shape[-1] // 2
    inv = ROPE_BASE ** (-jnp.arange(half, dtype=jnp.float32) / half)
    ang = pos[:, None] * inv[None, :]
    cos, sin = jnp.cos(ang), jnp.sin(ang)
    x1, x2 = x[..., :half], x[..., half:]
    return jnp.concatenate([x1 * cos - x2 * sin, x1 * sin + x2 * cos], axis=-1)


def retention_chunkwise(q, k, v):
    B, H, Lp, dk = q.shape
    dv = v.shape[-1]
    n = Lp // CHUNK
    log_g = jnp.log1p(-(2.0 ** (-5.0 - jnp.arange(H, dtype=jnp.float32))))
    idx = jnp.arange(CHUNK, dtype=jnp.float32)
    diff = idx[:, None] - idx[None, :]
    decay = jnp.where(diff >= 0, jnp.exp(log_g[:, None, None] * jnp.maximum(diff, 0.0)), 0.0)
    zeta = jnp.exp(log_g[:, None] * (CHUNK - 1.0 - idx))[:, :, None]
    xi = jnp.exp(log_g[:, None] * (idx + 1.0))[:, :, None]
    g_chunk = jnp.exp(log_g * CHUNK)[:, None, None]

    qc = q.reshape(B, H, n, CHUNK, dk)
    kc = k.reshape(B, H, n, CHUNK, dk)
    vc = v.reshape(B, H, n, CHUNK, dv)
    scores = jnp.einsum('bhncd,bhnsd->bhncs', qc, kc) * decay[:, None]
    inner = jnp.einsum('bhncs,bhnse->bhnce', scores, vc)

    def step(state, inp):
        q_i, k_i, v_i = inp
        cross = jnp.einsum('bhcd,bhde->bhce', q_i, state) * xi
        state = g_chunk * state + jnp.einsum('bhsd,bhse->bhde', k_i, v_i * zeta)
        return state, cross

    s0 = jnp.zeros((B, H, dk, dv), jnp.float32)
    _, cross = lax.scan(step, s0, (qc.transpose(2, 0, 1, 3, 4), kc.transpose(2, 0, 1, 3, 4), vc.transpose(2, 0, 1, 3, 4)))
    out = inner + cross.transpose(1, 2, 0, 3, 4)
    return out.reshape(B, H, Lp, dv)


def head_groupnorm(y):
    mu = jnp.mean(y, axis=-1, keepdims=True)
    var = jnp.mean(jnp.square(y - mu), axis=-1, keepdims=True)
    return (y - mu) * lax.rsqrt(var + GN_EPS)


def stick_breaking(q, k, v):
    Lp, d = q.shape[2], q.shape[3]
    scale = d ** -0.5
    outs = []
    for i in range(Lp // CHUNK):
        lk = (i + 1) * CHUNK
        q_blk = q[:, :, i * CHUNK:lk]
        k_pre, v_pre = k[:, :, :lk], v[:, :, :lk]
        z = jnp.einsum('bhtd,bhsd->bhts', q_blk, k_pre) * scale
        t_pos = i * CHUNK + jnp.arange(CHUNK)
        s_pos = jnp.arange(lk)
        valid = (s_pos[None, :] < t_pos[:, None]) & (s_pos[None, :] >= PAD)
        log_not = jnp.where(valid, jax.nn.log_sigmoid(-z), 0.0)
        after = lax.cumsum(log_not, axis=3, reverse=True) - log_not
        a = jnp.where(valid, jnp.exp(jax.nn.log_sigmoid(z) + after), 0.0)
        outs.append(jnp.einsum('bhts,bhse->bhte', a, v_pre))
    return jnp.concatenate(outs, axis=2)


def hybrid_mixer(hn, w_in, w_ret_out, w_sb_out, w_out):
    B, L, _ = hn.shape
    dtype = hn.dtype
    proj = hn @ w_in
    rq, rk, rv, rg, sq, sk, sv, ga, gb = jnp.split(proj, list(np.cumsum(PROJ_SPLIT)[:-1]), axis=-1)

    def heads(t, h):
        t = t.reshape(B, L, h, -1).transpose(0, 2, 1, 3).astype(jnp.float32)
        return jnp.pad(t, ((0, 0), (0, 0), (PAD, 0), (0, 0)))

    def merge_heads(t):
        t = t[:, :, PAD:]
        return t.transpose(0, 2, 1, 3).reshape(B, L, -1)

    pos = jnp.arange(L + PAD, dtype=jnp.float32) - PAD
    q_r = rotary(heads(rq, RET_HEADS), pos) * (RET_DK ** -0.5)
    k_r = rotary(heads(rk, RET_HEADS), pos)
    y_ret = head_groupnorm(retention_chunkwise(q_r, k_r, heads(rv, RET_HEADS)))
    y_ret = (jax.nn.silu(rg.astype(jnp.float32)) * merge_heads(y_ret)).astype(dtype) @ w_ret_out
    y_sb = merge_heads(stick_breaking(heads(sq, SB_HEADS), heads(sk, SB_HEADS), heads(sv, SB_HEADS)))
    y_sb = y_sb.astype(dtype) @ w_sb_out
    merged = jax.nn.sigmoid(ga) * y_ret + jax.nn.sigmoid(gb) * y_sb
    return merged @ w_out


def swiglu(hn, w_ffn_in, w_ffn_out):
    a, b = jnp.split(hn @ w_ffn_in, 2, axis=-1)
    return (jax.nn.silu(a) * b) @ w_ffn_out


def setup_inputs(seed: int = 0) -> dict:
    key = jax.random.key(seed)
    ks = jax.random.split(key, 12)
    f32 = jnp.float32
    nrm = lambda k, shape, fan: jax.random.normal(k, shape, f32) * (fan ** -0.5)
    gain = lambda k: 1.0 + 0.02 * jax.random.normal(k, (DEPTH, D_MODEL), f32)
    return {
        "x": jax.random.normal(ks[0], (BATCH, SEQ, D_MODEL), f32),
        "meta_tokens": jax.random.normal(ks[1], (N_META, D_MODEL), f32),
        "w_in": nrm(ks[2], (DEPTH, D_MODEL, PROJ_WIDTH), D_MODEL),
        "w_ret_out": nrm(ks[3], (DEPTH, RET_HEADS * RET_DV, D_MODEL), RET_HEADS * RET_DV),
        "w_sb_out": nrm(ks[4], (DEPTH, SB_HEADS * SB_DH, D_MODEL), SB_HEADS * SB_DH),
        "w_out": nrm(ks[5], (DEPTH, D_MODEL, D_MODEL), D_MODEL),
        "w_ffn_in": nrm(ks[6], (DEPTH, D_MODEL, 2 * D_FF), D_MODEL),
        "w_ffn_out": nrm(ks[7], (DEPTH, D_FF, D_MODEL), D_FF),
        "norm_mix_pre": gain(ks[8]),
        "norm_mix_post": gain(ks[9]),
        "norm_ffn_pre": gain(ks[10]),
        "norm_ffn_post": gain(ks[11]),
    }


def reference(x, meta_tokens, w_in, w_ret_out, w_sb_out, w_out, w_ffn_in, w_ffn_out,
              norm_mix_pre, norm_mix_post, norm_ffn_pre, norm_ffn_post):
    B = x.shape[0]
    meta = jnp.broadcast_to(meta_tokens.astype(x.dtype)[None], (B, N_META, x.shape[-1]))
    h = jnp.concatenate([meta, x], axis=1)
    for l in range(DEPTH):
        mix = hybrid_mixer(rmsnorm(h, norm_mix_pre[l]), w_in[l], w_ret_out[l], w_sb_out[l], w_out[l])
        h = h + rmsnorm(mix, norm_mix_post[l])
        ff = swiglu(rmsnorm(h, norm_ffn_pre[l]), w_ffn_in[l], w_ffn_out[l])
        h = h + rmsnorm(ff, norm_ffn_post[l])
    return h[:, N_META:]
```

```cpp
#include <hip/hip_runtime.h>
#include <cstdio>
#include <cstdint>
namespace pg8 {
#define PG8_LAS __attribute__((address_space(3)))
typedef unsigned short bf16_t;
typedef short bf16x8 __attribute__((ext_vector_type(8)));
typedef float f32x4 __attribute__((ext_vector_type(4)));
typedef unsigned u32x4 __attribute__((ext_vector_type(4)));
constexpr int BM = 256, BK = 64, HALF = 128, HTB = HALF * BK * 2  , STAGE_BYTES = 8 * HTB, NXCD = 8, WGM = 8;

__host__ __device__ __forceinline__ int lds_byte(int r, int c) { const int st = (r >> 4) * 2 + (c >> 5), rr = r & 15, cc = c & 31, ob = rr * 64 + cc * 2; return st * 1024 + (ob ^ (((ob >> 9) & 1) << 5)); }
__host__ __device__ __forceinline__ void stage_rc(int b, int& R, int& C) { const int st = b / 1024, sb = b % 1024, swz = sb ^ (((sb >> 9) & 1) << 5); R = (st >> 1) * 16 + swz / 64; C = (st & 1) * 32 + (swz % 64) / 2; }
__host__ __device__ __forceinline__ int perm32(int rho) { const int n = rho >> 4, i = rho & 15; return 8 * (i >> 2) + 4 * n + (i & 3); }

struct Unit { int pm, pn; };
struct Gemm { const bf16_t* A; const bf16_t* Bt; int M, N, K; };

struct StaticOrder {
    int nM, nN, nwg, G, c;
    __host__ __device__ void init(int M, int N, int G_, int c_) { nM = M / BM; nN = N / BM; nwg = nM * nN; G = G_; c = c_; }
    __host__ __device__ bool next(int i, Unit& u) const {
        const long L = (long)i * G + c; if (L >= nwg) return false;
        int wgid = (int)L; { const int q = nwg / NXCD, r = nwg % NXCD, xcd = wgid % NXCD, off = wgid / NXCD; wgid = (xcd < r ? xcd * (q + 1) : r * (q + 1) + (xcd - r) * q) + off; }
        const int nig = WGM * nN, gid = wgid / nig, fm = gid * WGM, gsz = (nM - fm) < WGM ? (nM - fm) : WGM;
        u.pm = fm + ((wgid % nig) % gsz); u.pn = (wgid % nig) / gsz; return true;
    }
    __device__ __forceinline__ void a_ready(const Unit&) const {}
    __device__ __forceinline__ void done(const Unit&) const {}
};

__device__ __forceinline__ unsigned cvt_pk_bf16(float lo, float hi) { unsigned r; asm volatile("v_cvt_pk_bf16_f32 %0, %1, %2" : "=v"(r) : "v"(lo), "v"(hi)); return r; }
typedef float f32x2 __attribute__((ext_vector_type(2)));
__device__ __forceinline__ f32x2 gelu_pk(f32x2 v) {
    const f32x2 av = __builtin_elementwise_abs(v), d = av * 0.2316418882f + 1.0f;
    f32x2 t; t.x = __builtin_amdgcn_rcpf(d.x); t.y = __builtin_amdgcn_rcpf(d.y);
    f32x2 q = t * 0.5307027145f + (-0.7265760135f); q = q * t + 0.7107068705f; q = q * t + (-0.142248368f); q = q * t + 0.127414796f; q = q * t;
    const f32x2 s = (v * v) * (-0.72134752044f);
    f32x2 e; e.x = __builtin_amdgcn_exp2f(s.x); e.y = __builtin_amdgcn_exp2f(s.y);
    const f32x2 m = v * (q * e), r = v - m;
    f32x2 o; o.x = v.x < 0.f ? m.x : r.x; o.y = v.y < 0.f ? m.y : r.y; return o;
}

template <int ACT  > struct EpiBf16 {
    static constexpr bool PERM = true, AFTER_DRAIN = false; static_assert(ACT == 0 || ACT == 1, "EpiBf16: ACT is 0 (none) or 1 (gelu_pk)");
    bf16_t* O; int ldc; const float* bias; int split_cols; size_t split_stride; float scale0;
    __device__ __forceinline__ void operator()(const f32x4 (&acc)[2][2][4][2], const Unit& u, int wr, int wc, int fr, int fq) const {
        const int row0 = u.pm * BM + wr * 64 + fr; int colt = u.pn * BM; bf16_t* base = O;
        float sc = 1.f; if (split_cols) { const int t = colt / split_cols; base += (size_t)t * split_stride; colt -= t * split_cols; if (t == 0) sc = scale0; }
        const int col0 = colt + wc * 32 + 8 * fq, bcol0 = u.pn * BM + wc * 32 + 8 * fq;
        f32x4 bv[2][2];
#pragma unroll
        for (int bj = 0; bj < 2; ++bj)
#pragma unroll
            for (int n = 0; n < 2; ++n) bv[bj][n] = bias ? *(const f32x4*)(bias + bcol0 + bj * HALF + 4 * n) : (f32x4){0.f, 0.f, 0.f, 0.f};
#pragma unroll
        for (int ai = 0; ai < 2; ++ai)
#pragma unroll
            for (int m = 0; m < 4; ++m) { bf16_t* rowp = base + (size_t)(row0 + ai * HALF + m * 16) * ldc + col0;
#pragma unroll
                for (int bj = 0; bj < 2; ++bj) { f32x4 v0 = acc[ai][bj][m][0] + bv[bj][0], v1 = acc[ai][bj][m][1] + bv[bj][1];
                    if (ACT == 1) { f32x2 a = gelu_pk((f32x2){v0[0], v0[1]}), b = gelu_pk((f32x2){v0[2], v0[3]}), c = gelu_pk((f32x2){v1[0], v1[1]}), d = gelu_pk((f32x2){v1[2], v1[3]});
                        v0 = (f32x4){a.x, a.y, b.x, b.y}; v1 = (f32x4){c.x, c.y, d.x, d.y}; }
                    v0 = v0 * sc; v1 = v1 * sc; u32x4 w; w.x = cvt_pk_bf16(v0[0], v0[1]); w.y = cvt_pk_bf16(v0[2], v0[3]); w.z = cvt_pk_bf16(v1[0], v1[1]); w.w = cvt_pk_bf16(v1[2], v1[3]);
                    *(u32x4*)(rowp + bj * HALF) = w; } }
    }
};

struct PanelStats {
    unsigned* xbuf;
    unsigned* cnt;
    unsigned* tmo;
    int ntn; float eps;
    unsigned code;
    __device__ __forceinline__ bool run(const f32x4 (&v)[2][2][4][2], const Unit& u, int wr, int wc, int fr, int fq, PG8_LAS unsigned char* lds, int wid, int lane) const {
        typedef float f32x2v __attribute__((ext_vector_type(2)));
        PG8_LAS f32x2v* P = (PG8_LAS f32x2v*)lds;
        PG8_LAS f32x2v* S = (PG8_LAS f32x2v*)(lds + 8192);
        PG8_LAS unsigned* flag = (PG8_LAS unsigned*)(lds + 8192 + 2048);
#pragma unroll
        for (int ai = 0; ai < 2; ++ai)
#pragma unroll
            for (int m = 0; m < 4; ++m) {
                float s = 0.f;
#pragma unroll
                for (int bj = 0; bj < 2; ++bj)
#pragma unroll
                    for (int n = 0; n < 2; ++n) { const f32x4 x = v[ai][bj][m][n]; s += (x[0] + x[1]) + (x[2] + x[3]); }
                s += __shfl_xor(s, 16); s += __shfl_xor(s, 32);
                const float mw = s * (1.0f / 64.0f); float q = 0.f;
#pragma unroll
                for (int bj = 0; bj < 2; ++bj)
#pragma unroll
                    for (int n = 0; n < 2; ++n) { const f32x4 d = v[ai][bj][m][n] - mw; q += (d[0] * d[0] + d[1] * d[1]) + (d[2] * d[2] + d[3] * d[3]); }
                q += __shfl_xor(q, 16); q += __shfl_xor(q, 32);
                if (fq == 0) P[(ai * HALF + wr * 64 + m * 16 + fr) * 4 + wc] = (f32x2v){mw, q};
            }
        asm volatile("s_waitcnt lgkmcnt(0)" ::: "memory"); __builtin_amdgcn_s_barrier(); asm volatile("" ::: "memory");
#if defined(BROKEN_EXCHANGE_NO_WAIT)
#warning BROKEN CONTROL BUILD: the row-statistics exchange does not wait; results are wrong by design
        if (blockIdx.x >= 64) { const long long t0_ = clock64(); while (clock64() - t0_ < 60000) __builtin_amdgcn_s_sleep(8); }
#endif
        const int row = wid * 32 + (lane & 31);
        if (lane < 32) {
            const f32x2v a = P[row * 4 + 0], b = P[row * 4 + 1], c = P[row * 4 + 2], d = P[row * 4 + 3];
            const float mt = (a.x + b.x + c.x + d.x) * 0.25f;
            const float da = a.x - mt, db = b.x - mt, dc = c.x - mt, dd = d.x - mt;
            const float m2 = (a.y + b.y) + (c.y + d.y) + 64.0f * ((da * da + db * db) + (dc * dc + dd * dd));
            unsigned long long* slot = (unsigned long long*)xbuf + ((size_t)(u.pm * BM + row) * 4 + u.pn);
            __hip_atomic_store(slot, ((unsigned long long)__float_as_uint(m2) << 32) | __float_as_uint(mt), __ATOMIC_RELAXED, __HIP_MEMORY_SCOPE_AGENT);
        }
        asm volatile("s_waitcnt vmcnt(0)" ::: "memory");
        if (lane == 0) __hip_atomic_fetch_add(cnt + 64 * u.pm, 1u, __ATOMIC_RELAXED, __HIP_MEMORY_SCOPE_AGENT);
        if (wid == 0) {
            bool dead = false; const unsigned long long t0 = __builtin_amdgcn_s_memrealtime(); const unsigned want = 8u * (unsigned)ntn;
            for (;;) {
#if defined(BROKEN_EXCHANGE_NO_WAIT)
                break;
#endif
                if ((unsigned)__builtin_amdgcn_readfirstlane(__hip_atomic_load(cnt + 64 * u.pm, __ATOMIC_RELAXED, __HIP_MEMORY_SCOPE_AGENT)) >= want) break;
                if (__builtin_amdgcn_s_memrealtime() - t0 > 2000000ull) {
                    if (lane == 0) { unsigned expect = 0u; __hip_atomic_compare_exchange_strong(tmo + 1, &expect, code | (unsigned)(u.pm & 0xff), __ATOMIC_RELAXED, __ATOMIC_RELAXED, __HIP_MEMORY_SCOPE_AGENT);
                                     __hip_atomic_store(tmo, 1u, __ATOMIC_RELAXED, __HIP_MEMORY_SCOPE_AGENT); }
                    dead = true; break; }
                __builtin_amdgcn_s_sleep(2);
            }
            __builtin_amdgcn_fence(__ATOMIC_ACQUIRE, "agent");
            if (lane == 0) flag[0] = dead ? 1u : 0u;
        }
        asm volatile("s_waitcnt vmcnt(0) lgkmcnt(0)" ::: "memory"); __builtin_amdgcn_s_barrier(); asm volatile("" ::: "memory");
        const bool bad = flag[0] != 0u;
        if (lane < 32) {
            const unsigned long long* slot = (const unsigned long long*)xbuf + (size_t)(u.pm * BM + row) * 4; float mt[4], m2[4]; float ms = 0.f;
#pragma unroll
            for (int t = 0; t < 4; ++t) { if (t < ntn) { const unsigned long long w = __hip_atomic_load(slot + t, __ATOMIC_RELAXED, __HIP_MEMORY_SCOPE_AGENT); mt[t] = __uint_as_float((unsigned)w); m2[t] = __uint_as_float((unsigned)(w >> 32)); } else { mt[t] = 0.f; m2[t] = 0.f; } ms += mt[t]; }
            const float mean = ms / (float)ntn; float q = 0.f;
#pragma unroll
            for (int t = 0; t < 4; ++t) if (t < ntn) { const float dm = mt[t] - mean; q += m2[t] + 256.0f * dm * dm; }
            S[row] = (f32x2v){mean, 1.0f / sqrtf(q / (256.0f * (float)ntn) + eps)};
        }
        asm volatile("s_waitcnt lgkmcnt(0)" ::: "memory"); __builtin_amdgcn_s_barrier(); asm volatile("" ::: "memory");
        return bad;
    }
};
struct EpiLnRes {
    static constexpr bool PERM = false, AFTER_DRAIN = true;
    const float* base; float* out; int ldc; const float* bias; PanelStats st; unsigned poison;
    __device__ __forceinline__ void fused(f32x4 (&acc)[2][2][4][2], const Unit& u, int wr, int wc, int fr, int fq, PG8_LAS unsigned char* lds, int wid, int lane) const {
        typedef float f32x2v __attribute__((ext_vector_type(2)));
        const PG8_LAS f32x2v* S = (const PG8_LAS f32x2v*)(lds + 8192);
        const int col0 = u.pn * BM + wc * 32 + 4 * fq;
#pragma unroll
        for (int bj = 0; bj < 2; ++bj)
#pragma unroll
            for (int n = 0; n < 2; ++n) { const f32x4 bv = bias ? *(const f32x4*)(bias + col0 + bj * HALF + n * 16) : (f32x4){0.f, 0.f, 0.f, 0.f};
#pragma unroll
                for (int ai = 0; ai < 2; ++ai)
#pragma unroll
                    for (int m = 0; m < 4; ++m) acc[ai][bj][m][n] += bv; }
        f32x4 pre[4][2][2];
#pragma unroll
        for (int m = 0; m < 4; ++m) { const size_t off = (size_t)(u.pm * BM + wr * 64 + m * 16 + fr) * ldc + col0;
#pragma unroll
            for (int bj = 0; bj < 2; ++bj)
#pragma unroll
                for (int n = 0; n < 2; ++n) pre[m][bj][n] = *(const f32x4*)(base + off + bj * HALF + n * 16); }
        const bool bad = st.run(acc, u, wr, wc, fr, fq, lds, wid, lane) || poison != 0u;
        const float qnan = __builtin_nanf("");
#pragma unroll
        for (int ai = 0; ai < 2; ++ai)
#pragma unroll
            for (int m = 0; m < 4; ++m) { const int r = ai * HALF + wr * 64 + m * 16 + fr; const f32x2v sr = S[r]; const size_t off = (size_t)(u.pm * BM + r) * ldc + col0;
#pragma unroll
                for (int bj = 0; bj < 2; ++bj)
#pragma unroll
                    for (int n = 0; n < 2; ++n) { const f32x4 bs = ai == 0 ? pre[m][bj][n] : *(const f32x4*)(base + off + bj * HALF + n * 16); f32x4 o = bs + (acc[ai][bj][m][n] - sr.x) * sr.y;
                        if (bad) o = (f32x4){qnan, qnan, qnan, qnan}; *(f32x4*)(out + off + bj * HALF + n * 16) = o; }
                if (m & 1) asm volatile("" ::: "memory"); }
    }
};
struct EpiLnResLn {
    static constexpr bool PERM = false, AFTER_DRAIN = true;
    const float* base; float* out; bf16_t* xn; int ldc; const float* bias; PanelStats st1, st2; unsigned poison;
    __device__ __forceinline__ void fused(f32x4 (&acc)[2][2][4][2], const Unit& u, int wr, int wc, int fr, int fq, PG8_LAS unsigned char* lds, int wid, int lane) const {
        typedef float f32x2v __attribute__((ext_vector_type(2))); typedef unsigned u32x2v __attribute__((ext_vector_type(2)));
        const PG8_LAS f32x2v* S = (const PG8_LAS f32x2v*)(lds + 8192);
        const int col0 = u.pn * BM + wc * 32 + 4 * fq;
#pragma unroll
        for (int bj = 0; bj < 2; ++bj)
#pragma unroll
            for (int n = 0; n < 2; ++n) { const f32x4 bv = bias ? *(const f32x4*)(bias + col0 + bj * HALF + n * 16) : (f32x4){0.f, 0.f, 0.f, 0.f};
#pragma unroll
                for (int ai = 0; ai < 2; ++ai)
#pragma unroll
                    for (int m = 0; m < 4; ++m) acc[ai][bj][m][n] += bv; }
        bool bad = st1.run(acc, u, wr, wc, fr, fq, lds, wid, lane) || poison != 0u;
        const float qnan = __builtin_nanf("");
#pragma unroll
        for (int ai = 0; ai < 2; ++ai)
#pragma unroll
            for (int m = 0; m < 4; ++m) { const int r = ai * HALF + wr * 64 + m * 16 + fr; const f32x2v sr = S[r]; const size_t off = (size_t)(u.pm * BM + r) * ldc + col0;
#pragma unroll
                for (int bj = 0; bj < 2; ++bj)
#pragma unroll
                    for (int n = 0; n < 2; ++n) { const f32x4 bs = *(const f32x4*)(base + off + bj * HALF + n * 16); acc[ai][bj][m][n] = bs + (acc[ai][bj][m][n] - sr.x) * sr.y; }
                asm volatile("" : "+v"(acc[ai][0][m][0]), "+v"(acc[ai][0][m][1]), "+v"(acc[ai][1][m][0]), "+v"(acc[ai][1][m][1]));
                if (m & 1) asm volatile("" ::: "memory"); }
        const bool bad1 = bad;
        bad = st2.run(acc, u, wr, wc, fr, fq, lds, wid, lane) || bad;
#pragma unroll
        for (int ai = 0; ai < 2; ++ai)
#pragma unroll
            for (int m = 0; m < 4; ++m) { const int r = ai * HALF + wr * 64 + m * 16 + fr; const f32x2v sr = S[r]; const size_t off = (size_t)(u.pm * BM + r) * ldc + col0;
#pragma unroll
                for (int bj = 0; bj < 2; ++bj)
#pragma unroll
                    for (int n = 0; n < 2; ++n) { const f32x4 x1 = acc[ai][bj][m][n]; *(f32x4*)(out + off + bj * HALF + n * 16) = bad1 ? (f32x4){qnan, qnan, qnan, qnan} : x1;
                        const f32x4 o = (x1 - sr.x) * sr.y; u32x2v w; w.x = cvt_pk_bf16(o[0], o[1]); w.y = cvt_pk_bf16(o[2], o[3]);
                        if (bad) { w.x = 0x7fc07fc0u; w.y = 0x7fc07fc0u; } *(u32x2v*)(xn + off + bj * HALF + n * 16) = w; }
                asm volatile("" ::: "memory"); }
    }
};

template <class Epi, class Sched, bool ALIGN_EPI = false, bool SP2 = false>
__device__ __forceinline__ void gemm_phase(PG8_LAS unsigned char* lds, const Gemm g, const Sched& S, const Epi& E) {
    int tid_ = threadIdx.x; asm volatile("" : "+v"(tid_));
    const int tid = tid_, wid = __builtin_amdgcn_readfirstlane(tid >> 6), lane = tid & 63, wr = wid >> 2, wc = wid & 3, fr = lane & 15, fq = lane >> 4;
    const int K = g.K, nt = K / BK;
    unsigned voffA[2], voffB[2];
#pragma unroll
    for (int i = 0; i < 2; ++i) { int R, C; stage_rc(tid * 16 + i * 8192, R, C); const int Rb = Epi::PERM ? ((R & ~31) + perm32(R & 31)) : R;
        voffA[i] = (unsigned)(R * K + C) * 2u; voffB[i] = (unsigned)(Rb * K + C) * 2u; }
    const size_t kstep = (size_t)(BK * 2);
    const size_t hstep = (size_t)HALF * K * 2;
    const size_t tstep = 2 * hstep;
    const unsigned ldsw = (unsigned)wid * 1024u;
    const int aoff = lds_byte(wr * 64 + fr, fq * 8), boff = lds_byte(wc * 32 + fr, fq * 8);
#define PG8_SA(b, h) (((b) * 2 + (h)) * HTB)
#define PG8_SB(b, h) ((4 + (b) * 2 + (h)) * HTB)
#define PG8_STAGE(bufoff, gbase, voff) do { _Pragma("unroll") for (int _i = 0; _i < 2; ++_i) \
        __builtin_amdgcn_global_load_lds((const unsigned*)((const char*)(gbase) + (voff)[_i]), (PG8_LAS unsigned*)(lds + (bufoff) + ldsw + _i * 8192), 16, 0, 0); } while (0)
#define PG8_LDA(dst, b, h) do { _Pragma("unroll") for (int m = 0; m < 4; ++m) _Pragma("unroll") for (int k = 0; k < 2; ++k) dst[m][k] = *(const PG8_LAS bf16x8*)(lds + PG8_SA(b, h) + aoff + m * 2048 + k * 1024); } while (0)
#define PG8_LDB(dst, b, h) do { _Pragma("unroll") for (int n = 0; n < 2; ++n) _Pragma("unroll") for (int k = 0; k < 2; ++k) dst[n][k] = *(const PG8_LAS bf16x8*)(lds + PG8_SB(b, h) + boff + n * 2048 + k * 1024); } while (0)
#define PG8_MMA(ai, bj, At, Bt) do { __builtin_amdgcn_s_setprio(1); _Pragma("unroll") for (int m = 0; m < 4; ++m) _Pragma("unroll") for (int n = 0; n < 2; ++n) _Pragma("unroll") for (int k = 0; k < 2; ++k) \
        acc[ai][bj][m][n] = __builtin_amdgcn_mfma_f32_16x16x32_bf16(Bt[n][k], At[m][k], acc[ai][bj][m][n], 0, 0, 0); __builtin_amdgcn_s_setprio(0); } while (0)
#define PG8_WAIT_V(n) asm volatile("s_waitcnt vmcnt(" #n ")" ::: "memory")
#define PG8_WAIT_L(n) asm volatile("s_waitcnt lgkmcnt(" #n ")" ::: "memory")
#define PG8_BAR __builtin_amdgcn_s_barrier()
#define PG8_SCHED __builtin_amdgcn_sched_barrier(0)
    Unit cur, nxt; int ui = 0;
    if (!S.next(0, cur)) return;
    f32x4 acc[2][2][4][2];
#pragma unroll
    for (int a = 0; a < 2; ++a)
#pragma unroll
        for (int b = 0; b < 2; ++b)
#pragma unroll
            for (int m = 0; m < 4; ++m)
#pragma unroll
                for (int n = 0; n < 2; ++n) acc[a][b][m][n] = (f32x4){0.f, 0.f, 0.f, 0.f};
    bf16x8 At[4][2], B0[2][2], B1[2][2];
    const char* cA = (const char*)g.A + (size_t)cur.pm * tstep; const char* cB = (const char*)g.Bt + (size_t)cur.pn * tstep;
    S.a_ready(cur);
    if constexpr (SP2) {
        PG8_STAGE(PG8_SB(0, 0), cB, voffB); PG8_STAGE(PG8_SB(0, 1), cB + hstep, voffB); PG8_STAGE(PG8_SA(0, 0), cA, voffA); PG8_STAGE(PG8_SA(0, 1), cA + hstep, voffA);
        if (wr == 1) PG8_BAR;
        PG8_WAIT_V(2); PG8_BAR;
        PG8_STAGE(PG8_SB(1, 0), cB + kstep, voffB); PG8_STAGE(PG8_SA(1, 0), cA + kstep, voffA); PG8_STAGE(PG8_SB(1, 1), cB + hstep + kstep, voffB);
        PG8_WAIT_V(6); PG8_BAR;
    } else {
        PG8_STAGE(PG8_SB(0, 0), cB, voffB); PG8_STAGE(PG8_SA(0, 0), cA, voffA); PG8_STAGE(PG8_SB(0, 1), cB + hstep, voffB); PG8_STAGE(PG8_SA(0, 1), cA + hstep, voffA);
        if (wr == 1) PG8_BAR;
        PG8_WAIT_V(4); PG8_BAR;
        PG8_STAGE(PG8_SB(1, 0), cB + kstep, voffB); PG8_STAGE(PG8_SA(1, 0), cA + kstep, voffA); PG8_STAGE(PG8_SB(1, 1), cB + hstep + kstep, voffB);
        PG8_WAIT_V(6); PG8_BAR;
    }
    for (;;) {
        const bool has_next = S.next(ui + 1, nxt);
        const char* nA = has_next ? (const char*)g.A + (size_t)nxt.pm * tstep : cA; const char* nB = has_next ? (const char*)g.Bt + (size_t)nxt.pn * tstep : cB;
        for (int t = 0; t < nt; t += 2) {
            const bool last = (t == nt - 2);
            const char* a1 = cA + (size_t)(t + 1) * kstep;
            const char* a2 = last ? nA : cA + (size_t)(t + 2) * kstep; const char* b2 = last ? nB : cB + (size_t)(t + 2) * kstep;
            const char* a3 = a2 + kstep; const char* b3 = b2 + kstep;
            if (last && has_next) S.a_ready(nxt);
            if constexpr (SP2) {
            PG8_LDB(B0, 0, 0); PG8_LDB(B1, 0, 1); PG8_SCHED; PG8_LDA(At, 0, 0); PG8_STAGE(PG8_SA(1, 1), a1 + hstep, voffA);
            PG8_WAIT_V(8); PG8_WAIT_L(0); PG8_BAR; PG8_MMA(0, 0, At, B0); PG8_MMA(0, 1, At, B1); PG8_BAR; PG8_SCHED;
            PG8_LDA(At, 0, 1); PG8_STAGE(PG8_SB(0, 0), b2, voffB); PG8_STAGE(PG8_SB(0, 1), b2 + hstep, voffB); PG8_STAGE(PG8_SA(0, 0), a2, voffA);
            PG8_WAIT_V(8); PG8_WAIT_L(0); PG8_BAR; PG8_MMA(1, 0, At, B0); PG8_MMA(1, 1, At, B1); PG8_BAR; PG8_SCHED;
            PG8_LDB(B0, 1, 0); PG8_LDB(B1, 1, 1); PG8_SCHED; PG8_LDA(At, 1, 0); PG8_STAGE(PG8_SA(0, 1), a2 + hstep, voffA);
            PG8_WAIT_V(8); PG8_WAIT_L(0); PG8_BAR; PG8_MMA(0, 0, At, B0); PG8_MMA(0, 1, At, B1); PG8_BAR; PG8_SCHED;
            PG8_LDA(At, 1, 1); PG8_STAGE(PG8_SB(1, 0), b3, voffB); PG8_STAGE(PG8_SB(1, 1), b3 + hstep, voffB); PG8_STAGE(PG8_SA(1, 0), a3, voffA);
            PG8_WAIT_V(8); PG8_WAIT_L(0); PG8_BAR; PG8_MMA(1, 0, At, B0); PG8_MMA(1, 1, At, B1); PG8_BAR; PG8_SCHED;
            } else {
            PG8_LDB(B0, 0, 0); PG8_SCHED; PG8_LDA(At, 0, 0); PG8_STAGE(PG8_SA(1, 1), a1 + hstep, voffA);
            PG8_WAIT_L(8); PG8_BAR; PG8_WAIT_L(0); PG8_MMA(0, 0, At, B0); PG8_BAR; PG8_SCHED;
            PG8_LDB(B1, 0, 1); PG8_STAGE(PG8_SB(0, 0), b2, voffB);
            PG8_BAR; PG8_WAIT_L(0); PG8_MMA(0, 1, At, B1); PG8_BAR;
            PG8_LDA(At, 0, 1); PG8_STAGE(PG8_SA(0, 0), a2, voffA);
            PG8_BAR; PG8_WAIT_L(0); PG8_MMA(1, 0, At, B0); PG8_BAR; PG8_SCHED;
            PG8_STAGE(PG8_SB(0, 1), b2 + hstep, voffB);
            PG8_WAIT_V(6); PG8_BAR; PG8_MMA(1, 1, At, B1); PG8_BAR;
            PG8_LDB(B0, 1, 0); PG8_SCHED; PG8_LDA(At, 1, 0); PG8_STAGE(PG8_SA(0, 1), a2 + hstep, voffA);
            PG8_WAIT_L(8); PG8_BAR; PG8_WAIT_L(0); PG8_MMA(0, 0, At, B0); PG8_BAR; PG8_SCHED;
            PG8_LDB(B1, 1, 1); PG8_STAGE(PG8_SB(1, 0), b3, voffB);
            PG8_BAR; PG8_WAIT_L(0); PG8_MMA(0, 1, At, B1); PG8_BAR;
            PG8_LDA(At, 1, 1); PG8_STAGE(PG8_SA(1, 0), a3, voffA);
            PG8_BAR; PG8_WAIT_L(0); PG8_MMA(1, 0, At, B0); PG8_BAR; PG8_SCHED;
            PG8_STAGE(PG8_SB(1, 1), b3 + hstep, voffB);
            PG8_WAIT_V(6); PG8_BAR; PG8_MMA(1, 1, At, B1); PG8_BAR;
            }
        }
        if constexpr (ALIGN_EPI) { if (wr == 0) PG8_BAR; }
        if constexpr (!Epi::AFTER_DRAIN) { E(acc, cur, wr, wc, fr, fq); S.done(cur); }
        if (!has_next) break;
#pragma unroll
        for (int a = 0; a < 2; ++a)
#pragma unroll
            for (int b = 0; b < 2; ++b)
#pragma unroll
                for (int m = 0; m < 4; ++m)
#pragma unroll
                    for (int n = 0; n < 2; ++n) acc[a][b][m][n] = (f32x4){0.f, 0.f, 0.f, 0.f};
        cur = nxt; cA = nA; cB = nB; ++ui;
        if constexpr (ALIGN_EPI) { if (wr == 1) PG8_BAR; }
    }
    PG8_WAIT_V(0);
    if constexpr (!ALIGN_EPI) { if (wr == 0) PG8_BAR; }
    PG8_BAR;
    if constexpr (Epi::AFTER_DRAIN) { E.fused(acc, cur, wr, wc, fr, fq, lds, wid, lane); S.done(cur); }
#undef PG8_SA
#undef PG8_SB
#undef PG8_STAGE
#undef PG8_LDA
#undef PG8_LDB
#undef PG8_MMA
#undef PG8_WAIT_V
#undef PG8_WAIT_L
#undef PG8_BAR
#undef PG8_SCHED
}
}
#define GAS __attribute__((address_space(1)))
#define LAS __attribute__((address_space(3)))
typedef unsigned short bf16;
typedef unsigned v4u __attribute__((ext_vector_type(4)));
typedef float f32x4 __attribute__((ext_vector_type(4)));
typedef short bf16x8 __attribute__((ext_vector_type(8)));
typedef GAS unsigned gu32;
typedef GAS unsigned long long gu64;
#define RLX_AGENT __ATOMIC_RELAXED, __HIP_MEMORY_SCOPE_AGENT
#define LDS_WAIT() asm volatile("s_waitcnt lgkmcnt(0)" ::: "memory")
#define VM_WAIT() asm volatile("s_waitcnt vmcnt(0)" ::: "memory")
__device__ __forceinline__ unsigned long long rt() { return __builtin_amdgcn_s_memrealtime(); }
__device__ __forceinline__ unsigned f2bf(float f) { unsigned u = __builtin_bit_cast(unsigned, f); return (u + 0x7fffu + ((u >> 16) & 1u)) >> 16; }
__device__ __forceinline__ unsigned pk2(float lo, float hi) { return f2bf(lo) | (f2bf(hi) << 16); }

#define XB_TMO      128
#define XB_XCNT(j)  (256  + 64 * (j))
#define XB_XSUB(j)  (1280 + 64 * (j))
#define XB_XGEN(j)  (2304 + 64 * (j))
#define XB_TOP      3328
#define XB_TOPGEN   3392
#define XCD_BAR_WORDS 3456
#define XB_SPIN_CAP (1u << 18)
#ifndef XB_ACQ_SCOPE
#define XB_ACQ_SCOPE ""
#endif

__device__ __forceinline__ unsigned xb_ld(unsigned* p)              { return __hip_atomic_load(p, __ATOMIC_RELAXED, __HIP_MEMORY_SCOPE_AGENT); }
__device__ __forceinline__ unsigned xb_add(unsigned* p, unsigned v) { return __hip_atomic_fetch_add(p, v, __ATOMIC_RELAXED, __HIP_MEMORY_SCOPE_AGENT); }
__device__ __forceinline__ unsigned xb_xcc_id() { return (unsigned)__builtin_amdgcn_s_getreg((3 << 11) | 20) & 0xFu; }
#define XB_SPIN(cond, bar) do { unsigned _sp = 0; while (cond) { __builtin_amdgcn_s_sleep(1); \
    if ((++_sp & 255u) == 0u) { if (xb_ld(&(bar)[XB_TMO])) break; if (_sp > XB_SPIN_CAP) { atomicAdd(&(bar)[XB_TMO], 1u); break; } } } } while (0)

struct XcdBarrier {
    unsigned* bar; unsigned x;
    volatile LAS unsigned* st;
};

__device__ __forceinline__ XcdBarrier xcd_barrier_post(unsigned* bar, volatile LAS unsigned* st) {
    XcdBarrier b; b.bar = bar; b.x = xb_xcc_id(); b.st = st;
    if (threadIdx.x == 0) (void)xb_add(&bar[XB_XCNT(b.x)], 1u);
    return b;
}
__device__ __forceinline__ void xcd_barrier_complete(unsigned* bar, unsigned x, unsigned& nloc, unsigned& nx) {
    const unsigned G = gridDim.x * gridDim.y * gridDim.z;
    unsigned sum, cnt, mine, sp = 0u;
    for (;;) {
        sum = 0u; cnt = 0u; mine = 0u;
#pragma unroll
        for (unsigned j = 0; j < 16; ++j) { const unsigned c = xb_ld(&bar[XB_XCNT(j)]); sum += c; cnt += (c > 0u) ? 1u : 0u; mine = (j == x) ? c : mine; }
        if (sum == G) break;
        __builtin_amdgcn_s_sleep(1);
        if ((++sp & 255u) == 0u) { if (xb_ld(&bar[XB_TMO])) break; if (sp > XB_SPIN_CAP) { atomicAdd(&bar[XB_TMO], 1u); break; } }
    }
    nloc = mine > 0u ? mine : 1u; nx = cnt > 0u ? cnt : 1u;
}

__device__ __forceinline__ void xcd_barrier(const XcdBarrier& b) {
    asm volatile("s_waitcnt vmcnt(0)" ::: "memory");
    __syncthreads();
    if (threadIdx.x == 0) {
        unsigned* bar = b.bar;
        __builtin_amdgcn_s_waitcnt(0);
        unsigned nloc = b.st[0], nx = b.st[1];
        if (nloc == 0u) { xcd_barrier_complete(bar, b.x, nloc, nx); b.st[0] = nloc; b.st[1] = nx; }
        const unsigned old = xb_add(&bar[XB_XSUB(b.x)], 1u);
        const unsigned gen = old / nloc;
        if (old + 1u == (gen + 1u) * nloc) {
            __builtin_amdgcn_fence(__ATOMIC_RELEASE, "agent");
            asm volatile("s_waitcnt vmcnt(0)" ::: "memory");
            const unsigned og = xb_add(&bar[XB_TOP], 1u);
            const unsigned tg = og / nx;
            if (og + 1u == (tg + 1u) * nx) xb_add(&bar[XB_TOPGEN], 1u);
            else XB_SPIN(xb_ld(&bar[XB_TOPGEN]) == tg, bar);
            __builtin_amdgcn_fence(__ATOMIC_ACQUIRE, XB_ACQ_SCOPE);
            xb_add(&bar[XB_XGEN(b.x)], 1u);
            asm volatile("s_waitcnt vmcnt(0)" ::: "memory");
        } else {
            XB_SPIN(xb_ld(&bar[XB_XGEN(b.x)]) == gen, bar);
            __builtin_amdgcn_fence(__ATOMIC_ACQUIRE, XB_ACQ_SCOPE);
            asm volatile("s_waitcnt vmcnt(0)" ::: "memory");
        }
    }
    __syncthreads();
}

constexpr int NB = 2, T = 8192, DM = 1024, M = NB * T, NMETA = 16, LK = T + NMETA;
constexpr int DFF = 2816, PW = 11264;
constexpr float NORM_EPS = 1e-6f, GN_EPS = 1e-5f;
constexpr int NWAVES = 8;
constexpr float LOG2E = 1.4426950408889634f;
constexpr float ROPE_C = 13.287712379549449f / 128.0f;
constexpr float INV_2PI = 0.15915494309189535f;

typedef float f32x16 __attribute__((ext_vector_type(16)));
typedef short s16x4 __attribute__((ext_vector_type(4)));
typedef short v4i16_t __attribute__((ext_vector_type(4)));
typedef float f32x2v __attribute__((ext_vector_type(2)));
typedef unsigned u32x2v __attribute__((ext_vector_type(2)));

constexpr size_t MiB = 1u << 20;
constexpr size_t WS_CTL = 0, CTL_ZERO_BYTES = 1 * MiB;
constexpr size_t WS_WIN = 1 * MiB, WS_WRO = 23 * MiB, WS_WSO = 27 * MiB, WS_WOUT = 29 * MiB, WS_WFI = 31 * MiB, WS_WFO = 42 * MiB;
constexpr size_t WS_MP = 47 * MiB + 512 * 1024;
constexpr size_t WS_GS = 48 * MiB;
constexpr size_t WS_XN = 49 * MiB;
constexpr size_t WS_R = 81 * MiB;
constexpr size_t WS_RQ = WS_R;
constexpr size_t WS_RK = WS_R + 32 * MiB;
constexpr size_t WS_PB = WS_R + 64 * MiB;
constexpr size_t WS_MKV = 47 * MiB + 512 * 1024 + 384 * 1024;
constexpr size_t WS_YR = 192 * MiB;
constexpr size_t WS_GA = WS_RK, WS_GB = WS_R + 64 * MiB;
constexpr size_t WS_MG = WS_XN;
constexpr size_t WS_HN2 = WS_RK;
constexpr size_t WS_ACT = WS_R + 64 * MiB;
constexpr size_t WS_FF = WS_R;
constexpr size_t WS_END = 256 * MiB;
static_assert(WS_MKV + 65536 <= WS_GS, "ws map");
static_assert(WS_ACT + (size_t)M * DFF * 2 <= WS_END && WS_WFO + (size_t)DM * DFF * 2 <= WS_MP, "ws map");
constexpr int CW_BAR = 4096, CW_TICKET = 1024  , CW_BAD = 2000;

constexpr int RING_BYTES = 131072;
constexpr int LDSCTL_OFF = RING_BYTES, MISC_OFF = LDSCTL_OFF + 320;
constexpr int LDS_BYTES = 147456;

typedef pg8::Unit Unit;

typedef __bf16 bf16x2_t __attribute__((ext_vector_type(2)));
__device__ __forceinline__ unsigned cvtpk_s(float lo, float hi) { f32x2v v = {lo, hi}; bf16x2_t b = __builtin_convertvector(v, bf16x2_t); return __builtin_bit_cast(unsigned, b); }
__device__ __forceinline__ float fsigmoid(float x) { return __builtin_amdgcn_rcpf(1.f + __builtin_amdgcn_exp2f(-LOG2E * x)); }
__device__ __forceinline__ int opaque(int v) { asm volatile("" : "+v"(v)); return v; }
__device__ __forceinline__ int crow(int reg, int h) { return (reg & 3) + 8 * (reg >> 2) + 4 * h; }
__device__ __forceinline__ v4u pack8(const f32x4& a, const f32x4& b) { v4u w; w.x = cvtpk_s(a[0], a[1]); w.y = cvtpk_s(a[2], a[3]); w.z = cvtpk_s(b[0], b[1]); w.w = cvtpk_s(b[2], b[3]); return w; }
__device__ __forceinline__ float bf2f(unsigned short b) { return __uint_as_float(((unsigned)b) << 16); }
__device__ __forceinline__ void unpack8(const v4u& w, float (&o)[8]) {
    o[0] = __uint_as_float(w.x << 16); o[1] = __uint_as_float(w.x & 0xffff0000u); o[2] = __uint_as_float(w.y << 16); o[3] = __uint_as_float(w.y & 0xffff0000u);
    o[4] = __uint_as_float(w.z << 16); o[5] = __uint_as_float(w.z & 0xffff0000u); o[6] = __uint_as_float(w.w << 16); o[7] = __uint_as_float(w.w & 0xffff0000u); }
__device__ __forceinline__ s16x4 tr_read(const LAS unsigned char* p) { return __builtin_bit_cast(s16x4, __builtin_amdgcn_ds_read_tr16_b64_v4i16((LAS v4i16_t*)p)); }
__device__ __forceinline__ bf16x8 cat8(s16x4 lo, s16x4 hi) { return (bf16x8){lo[0], lo[1], lo[2], lo[3], hi[0], hi[1], hi[2], hi[3]}; }
#define MFMA32(a, b, c) __builtin_amdgcn_mfma_f32_32x32x16_bf16((a), (b), (c), 0, 0, 0)

struct EpiP1 {
    static constexpr bool PERM = true, AFTER_DRAIN = false;
    bf16* RQ; bf16* RK; bf16* RV;
    __device__ __forceinline__ void operator()(const f32x4 (&acc)[2][2][4][2], const Unit& u, int wr, int wc, int fr, int fq) const {
        int pm_ = u.pm, pn_ = u.pn; asm volatile("" : "+s"(pm_), "+s"(pn_)); const int row0 = pm_ * 256 + wr * 64 + fr; const int pn = pn_;
        if (pn >= 8) {
            const int col0 = (pn - 8) * 256 + wc * 32 + 8 * fq;
            const __amdgpu_buffer_rsrc_t rsrc = __builtin_amdgcn_make_buffer_rsrc((void*)RV, 0, M * 2048 * 2, 0x00020000);
#pragma unroll
            for (int ai = 0; ai < 2; ++ai)
#pragma unroll
                for (int m = 0; m < 4; ++m) { const int boff = ((row0 + ai * 128 + m * 16) * 2048 + col0) * 2;
#pragma unroll
                    for (int bj = 0; bj < 2; ++bj) __builtin_amdgcn_raw_buffer_store_b128(pack8(acc[ai][bj][m][0], acc[ai][bj][m][1]), rsrc, boff + bj * 256, 0, 16); }
        } else {
            const bool isq = pn < 4; const int h = pn & 3;
            bf16* base = (isq ? RQ : RK) + h * 256 + wc * 32 + 8 * fq;
            float cj[2][4];
#pragma unroll
            for (int n = 0; n < 2; ++n)
#pragma unroll
                for (int i = 0; i < 4; ++i) cj[n][i] = __builtin_amdgcn_exp2f(-(float)(wc * 32 + 8 * fq + 4 * n + i) * ROPE_C) * INV_2PI;
            const float lg2 = log2f(1.f - exp2f(-(float)(5 + h)));
#pragma unroll
            for (int ai = 0; ai < 2; ++ai)
#pragma unroll
                for (int m = 0; m < 4; ++m) {
                    const int r = row0 + ai * 128 + m * 16; const int t = r & (T - 1); const float pos = (float)(t + NMETA); const float c = (float)(t & 127);
                    const float rs = isq ? 0.0625f * __builtin_amdgcn_exp2f(lg2 * c) : __builtin_amdgcn_exp2f(-lg2 * c);
                    f32x4 o1[2], o2[2]; f32x4 xa[2] = {acc[ai][0][m][0], acc[ai][0][m][1]}, xb[2] = {acc[ai][1][m][0], acc[ai][1][m][1]};
                    asm volatile("" : "+v"(xa[0]), "+v"(xa[1]), "+v"(xb[0]), "+v"(xb[1]));
#pragma unroll
                    for (int n = 0; n < 2; ++n)
#pragma unroll
                        for (int i = 0; i < 4; ++i) {
                            const float x1 = xa[n][i], x2 = xb[n][i];
                            const float rev = __builtin_amdgcn_fractf(pos * cj[n][i]);
                            const float sn = __builtin_amdgcn_sinf(rev), cs = __builtin_amdgcn_cosf(rev);
                            o1[n][i] = (x1 * cs - x2 * sn) * rs; o2[n][i] = (x1 * sn + x2 * cs) * rs; }
                    bf16* rowp = base + (size_t)r * DM;
                    *(v4u*)(rowp) = pack8(o1[0], o1[1]); *(v4u*)(rowp + 128) = pack8(o2[0], o2[1]); asm volatile("" ::: "memory"); }
        }
    }
};
struct EpiP3 {
    static constexpr bool PERM = true, AFTER_DRAIN = false;
    bf16* SQ; bf16* SK; bf16* SV;
    __device__ __forceinline__ void operator()(const f32x4 (&acc)[2][2][4][2], const Unit& u, int wr, int wc, int fr, int fq) const {
        int pm_ = u.pm, pn_ = u.pn; asm volatile("" : "+s"(pm_), "+s"(pn_)); const int row0 = pm_ * 256 + wr * 64 + fr; const int pn = pn_; const int sel = pn >> 2;
        const int col0 = (pn & 3) * 256 + wc * 32 + 8 * fq;
        bf16* base = SQ + (sel >= 1 ? (SK - SQ) : 0) + (sel >= 2 ? (SV - SK) : 0);
        const float sc = sel == 0 ? 0.125f * LOG2E : 1.f;
#pragma unroll
        for (int ai = 0; ai < 2; ++ai)
#pragma unroll
            for (int m = 0; m < 4; ++m) { const int r = row0 + ai * 128 + m * 16;
                bf16* rowp = base + (size_t)r * DM + col0;
#pragma unroll
                for (int bj = 0; bj < 2; ++bj) *(v4u*)(rowp + bj * 128) = pack8(acc[ai][bj][m][0] * sc, acc[ai][bj][m][1] * sc);
                asm volatile("" ::: "memory"); }
    }
};
struct EpiRG {
    static constexpr bool PERM = true, AFTER_DRAIN = false;
    bf16* YR; const f32x2v* GS;
    __device__ __forceinline__ void operator()(const f32x4 (&acc)[2][2][4][2], const Unit& u, int wr, int wc, int fr, int fq) const {
        int pm_ = u.pm, pn_ = u.pn; asm volatile("" : "+s"(pm_), "+s"(pn_)); const int row0 = pm_ * 256 + wr * 64 + fr; const int pn = pn_;
        const int h = pn >> 1; const int col0 = pn * 256 + wc * 32 + 8 * fq;
#pragma unroll
        for (int ai = 0; ai < 2; ++ai)
#pragma unroll
            for (int m = 0; m < 4; ++m) { const int r = row0 + ai * 128 + m * 16; const f32x2v st = GS[(size_t)r * 4 + h];
                bf16* rowp = YR + (size_t)r * 2048 + col0;
#pragma unroll
                for (int bj = 0; bj < 2; ++bj) { const v4u yv = *(const v4u*)(rowp + bj * 128); float y[8]; unpack8(yv, y);
                    f32x4 o0, o1;
                    f32x4 xa = acc[ai][bj][m][0], xb = acc[ai][bj][m][1]; asm volatile("" : "+v"(xa), "+v"(xb));
#pragma unroll
                    for (int i = 0; i < 4; ++i) { const float a = xa[i], b = xb[i];
                        o0[i] = a * fsigmoid(a) * ((y[i] - st.x) * st.y); o1[i] = b * fsigmoid(b) * ((y[4 + i] - st.x) * st.y); }
                    *(v4u*)(rowp + bj * 128) = pack8(o0, o1); }
                asm volatile("" ::: "memory"); }
    }
};
struct EpiSig {
    static constexpr bool PERM = true, AFTER_DRAIN = false;
    bf16* GA; bf16* GB;
    __device__ __forceinline__ void operator()(const f32x4 (&acc)[2][2][4][2], const Unit& u, int wr, int wc, int fr, int fq) const {
        int pm_ = u.pm, pn_ = u.pn; asm volatile("" : "+s"(pm_), "+s"(pn_)); const int row0 = pm_ * 256 + wr * 64 + fr; const int pn = pn_;
        bf16* base = GA + (pn >= 4 ? (GB - GA) : 0); const int col0 = (pn & 3) * 256 + wc * 32 + 8 * fq;
#pragma unroll
        for (int ai = 0; ai < 2; ++ai)
#pragma unroll
            for (int m = 0; m < 4; ++m) { bf16* rowp = base + (size_t)(row0 + ai * 128 + m * 16) * DM + col0;
#pragma unroll
                for (int bj = 0; bj < 2; ++bj) { f32x4 o0, o1;
                    f32x4 xa = acc[ai][bj][m][0], xb = acc[ai][bj][m][1]; asm volatile("" : "+v"(xa), "+v"(xb));
#pragma unroll
#if defined(DEBUG_SIGID)
                    for (int i = 0; i < 4; ++i) { o0[i] = xa[i]; o1[i] = xb[i]; }
#else
                    for (int i = 0; i < 4; ++i) { o0[i] = fsigmoid(xa[i]); o1[i] = fsigmoid(xb[i]); }
#endif
                    *(v4u*)(rowp + bj * 128) = pack8(o0, o1); }
                asm volatile("" ::: "memory"); }
    }
};
template <bool SECOND> struct EpiP6 {
    static constexpr bool PERM = true, AFTER_DRAIN = false;
    bf16* MG; const bf16* GT;
    __device__ __forceinline__ void operator()(const f32x4 (&acc)[2][2][4][2], const Unit& u, int wr, int wc, int fr, int fq) const {
        int pm_ = u.pm, pn_ = u.pn; asm volatile("" : "+s"(pm_), "+s"(pn_)); const int row0 = pm_ * 256 + wr * 64 + fr; const int col0 = pn_ * 256 + wc * 32 + 8 * fq;
#pragma unroll
        for (int ai = 0; ai < 2; ++ai)
#pragma unroll
            for (int m = 0; m < 4; ++m) { const size_t off = (size_t)(row0 + ai * 128 + m * 16) * DM + col0;
#pragma unroll
                for (int bj = 0; bj < 2; ++bj) { const v4u gv = *(const v4u*)(GT + off + bj * 128); float g[8]; unpack8(gv, g); float p[8];
                    if (SECOND) { const v4u pv = *(const v4u*)(MG + off + bj * 128); unpack8(pv, p); }
                    f32x4 o0, o1;
#pragma unroll
                    for (int i = 0; i < 4; ++i) { o0[i] = acc[ai][bj][m][0][i] * g[i]; o1[i] = acc[ai][bj][m][1][i] * g[4 + i]; if (SECOND) { o0[i] += p[i]; o1[i] += p[4 + i]; } }
                    *(v4u*)(MG + off + bj * 128) = pack8(o0, o1); }
                asm volatile("" ::: "memory"); }
    }
};
struct EpiF32 {
    static constexpr bool PERM = false, AFTER_DRAIN = false;
    float* C; int ldc;
    __device__ __forceinline__ void operator()(const f32x4 (&acc)[2][2][4][2], const Unit& u, int wr, int wc, int fr, int fq) const {
        int pm_ = u.pm, pn_ = u.pn; asm volatile("" : "+s"(pm_), "+s"(pn_)); const int row0 = pm_ * 256 + wr * 64 + fr, col0 = pn_ * 256 + wc * 32 + 4 * fq;
#pragma unroll
        for (int ai = 0; ai < 2; ++ai)
#pragma unroll
            for (int m = 0; m < 4; ++m) { float* rowp = C + (size_t)(row0 + ai * 128 + m * 16) * ldc + col0;
#pragma unroll
                for (int bj = 0; bj < 2; ++bj)
#pragma unroll
                    for (int n = 0; n < 2; ++n) *(f32x4*)(rowp + bj * 128 + n * 16) = acc[ai][bj][m][n]; }
    }
};
struct EpiP8 {
    static constexpr bool PERM = true, AFTER_DRAIN = false;
    bf16* ACT;
    __device__ __forceinline__ void operator()(const f32x4 (&acc)[2][2][4][2], const Unit& u, int wr, int wc, int fr, int fq) const {
        int pm_ = u.pm, pn_ = u.pn; asm volatile("" : "+s"(pm_), "+s"(pn_)); const int row0 = pm_ * 256 + wr * 64 + fr; const int col0 = pn_ * 128 + wc * 32 + 8 * fq;
#pragma unroll
        for (int ai = 0; ai < 2; ++ai)
#pragma unroll
            for (int m = 0; m < 4; ++m) { bf16* rowp = ACT + (size_t)(row0 + ai * 128 + m * 16) * DFF + col0; f32x4 o0, o1;
                f32x4 xa = acc[ai][0][m][0], xb = acc[ai][0][m][1]; asm volatile("" : "+v"(xa), "+v"(xb));
#pragma unroll
                for (int i = 0; i < 4; ++i) { const float a0 = xa[i], a1 = xb[i];
                    o0[i] = a0 * fsigmoid(a0) * acc[ai][1][m][0][i]; o1[i] = a1 * fsigmoid(a1) * acc[ai][1][m][1][i]; }
                *(v4u*)rowp = pack8(o0, o1); asm volatile("" ::: "memory"); }
    }
};

struct Frame {
    LAS unsigned char* lds;
    volatile LAS unsigned* MISC;
    gu32* ctl;
    int tid, lane, wave;
    int vcu, G;
    int xcc, tk, cg;
    const float *x, *meta, *w_in, *w_ro, *w_so, *w_out, *w_fi, *w_fo, *g_pre, *g_post, *g_fpre, *g_fpost; float* out;
    unsigned char* ws;
};
__device__ __forceinline__ float wave_sum(float v) {
#pragma unroll
    for (int o = 1; o < 64; o <<= 1) v += __shfl_xor(v, o);
    return v;
}
__device__ __forceinline__ void p0_transpose_item(const float* W, int K, int N, bf16* WT, int dst_row0, LAS float* scr, int kb, int nb, int lane) {
    const int k0 = 64 * kb, n0 = 32 * nb;
#pragma unroll 8
    for (int i = 0; i < 32; ++i) { const int kk = 2 * i + (lane >> 5); scr[kk * 33 + (lane & 31)] = W[(size_t)(k0 + kk) * N + n0 + (lane & 31)]; }
    LDS_WAIT(); asm volatile("" ::: "memory");
    const int c = lane & 7;
#pragma unroll
    for (int j = 0; j < 4; ++j) { const int n = (lane >> 3) + 8 * j; const LAS float* s = scr + (8 * c) * 33 + n;
        v4u o; o.x = pk2(s[0 * 33], s[1 * 33]); o.y = pk2(s[2 * 33], s[3 * 33]); o.z = pk2(s[4 * 33], s[5 * 33]); o.w = pk2(s[6 * 33], s[7 * 33]);
        *(GAS v4u*)(WT + (size_t)(dst_row0 + n) * K + k0 + 8 * c) = o; }
    LDS_WAIT(); asm volatile("" ::: "memory");
}
__device__ __forceinline__ int map_in(int n) { return n < 4096 ? n : (n < 6144 ? n + 3072 : (n < 9216 ? n - 2048 : n)); }
__device__ __forceinline__ int map_fi(int n) { return n < DFF ? (n >> 7) * 256 + (n & 127) : ((n - DFF) >> 7) * 256 + 128 + ((n - DFF) & 127); }
__device__ __forceinline__ void rms_row_to_bf16(const float* xrow, const float* gain, bf16* orow, int lane) {
    const GAS f32x4* xr = (const GAS f32x4*)xrow + lane; const GAS f32x4* gr = (const GAS f32x4*)gain + lane;
    f32x4 v[4]; float s = 0.f;
#pragma unroll
    for (int j = 0; j < 4; ++j) { v[j] = xr[64 * j]; s += (v[j].x * v[j].x + v[j].y * v[j].y) + (v[j].z * v[j].z + v[j].w * v[j].w); }
    const float rs = 1.f / sqrtf(wave_sum(s) * (1.f / DM) + NORM_EPS);
    GAS unsigned long long* o8 = (GAS unsigned long long*)orow + lane;
#pragma unroll
    for (int j = 0; j < 4; ++j) { const f32x4 g = gr[64 * j]; o8[64 * j] = (unsigned long long)pk2(v[j].x * rs * g.x, v[j].y * rs * g.y) | ((unsigned long long)pk2(v[j].z * rs * g.z, v[j].w * rs * g.w) << 32); }
}

__device__ __forceinline__ void p0_prologue(Frame& F0) {
    Frame F = F0; F.tid = opaque((int)threadIdx.x); F.lane = F.tid & 63; F.wave = __builtin_amdgcn_readfirstlane(F.tid >> 6);
    bf16* WIN = (bf16*)(F.ws + WS_WIN); bf16* WRO = (bf16*)(F.ws + WS_WRO); bf16* WSO = (bf16*)(F.ws + WS_WSO); bf16* WOUT = (bf16*)(F.ws + WS_WOUT);
    bf16* WFI = (bf16*)(F.ws + WS_WFI); bf16* WFO = (bf16*)(F.ws + WS_WFO); bf16* XN = (bf16*)(F.ws + WS_XN); float* MP = (float*)(F.ws + WS_MP);
    if (F.vcu < 80) {
        LAS float* hnT = (LAS float*)F.lds;
        LAS float* red = hnT + 16 * 1024;
#pragma unroll
        for (int rr = 0; rr < 2; ++rr) { const int row = 2 * F.wave + rr; const float* mr = F.meta + (size_t)row * DM;
            float v[16]; float s = 0.f;
#pragma unroll
            for (int j = 0; j < 16; ++j) { v[j] = mr[F.lane + 64 * j]; s += v[j] * v[j]; }
            const float rs = 1.f / sqrtf(wave_sum(s) * (1.f / DM) + NORM_EPS);
#pragma unroll
            for (int j = 0; j < 16; ++j) hnT[(F.lane + 64 * j) * 16 + row] = v[j] * rs * F.g_pre[F.lane + 64 * j]; }
        __syncthreads();
        const int mpcol = 64 * F.vcu + F.lane; const int orig = mpcol < 3072 ? mpcol + 1024 : mpcol + 4096;
        float acc[16];
#pragma unroll
        for (int i = 0; i < 16; ++i) acc[i] = 0.f;
        const float* wp = F.w_in + (size_t)(128 * F.wave) * PW + orig;
#pragma unroll 8
        for (int k = 0; k < 128; ++k) { const float wv = wp[(size_t)k * PW]; const LAS f32x4* hv = (const LAS f32x4*)(hnT + (128 * F.wave + k) * 16);
#pragma unroll
            for (int q = 0; q < 4; ++q) { const f32x4 hq = hv[q]; acc[4 * q] += hq.x * wv; acc[4 * q + 1] += hq.y * wv; acc[4 * q + 2] += hq.z * wv; acc[4 * q + 3] += hq.w * wv; } }
#pragma unroll
        for (int i = 0; i < 16; ++i) red[(F.wave * 16 + i) * 64 + F.lane] = acc[i];
        __syncthreads();
        for (int o = F.tid; o < 1024; o += 512) { const int i = o >> 6, c = o & 63; float s = 0.f;
#pragma unroll
            for (int w = 0; w < 8; ++w) s += red[(w * 16 + i) * 64 + c];
            MP[i * 5120 + 64 * F.vcu + c] = s;
            const int mc = 64 * F.vcu + c; bf16* MKV = (bf16*)(F.ws + WS_MKV);
            if (mc >= 3072) MKV[(mc >= 4096 ? 16 * DM + (mc - 4096) : (mc - 3072)) + i * DM] = (bf16)f2bf(s); }
        __syncthreads();
    }
    LAS float* scr = (LAS float*)(F.lds + F.wave * 16384);
    const int gw = F.vcu * NWAVES + F.wave, NGW = F.G * NWAVES;
    constexpr int I_IN = 16 * (PW / 32), I_RO = 32 * 32, I_SO = 16 * 32, I_OUT = 16 * 32, I_FI = 16 * (2 * DFF / 32), I_FO = (DFF / 64) * 32;
    constexpr int NITEMS = I_IN + I_RO + I_SO + I_OUT + I_FI + I_FO;
    for (int it = gw; it < NITEMS; it += NGW) {
        int r = it;
        if (r < I_IN) { const int nbk = PW / 32, kb = r / nbk, nb = r % nbk; p0_transpose_item(F.w_in, DM, PW, WIN, map_in(32 * nb), scr, kb, nb, F.lane); continue; } r -= I_IN;
        if (r < I_RO) { const int kb = r / 32, nb = r % 32; p0_transpose_item(F.w_ro, 2048, DM, WRO, 32 * nb, scr, kb, nb, F.lane); continue; } r -= I_RO;
        if (r < I_SO) { const int kb = r / 32, nb = r % 32; p0_transpose_item(F.w_so, DM, DM, WSO, 32 * nb, scr, kb, nb, F.lane); continue; } r -= I_SO;
        if (r < I_OUT) { const int kb = r / 32, nb = r % 32; p0_transpose_item(F.w_out, DM, DM, WOUT, 32 * nb, scr, kb, nb, F.lane); continue; } r -= I_OUT;
        if (r < I_FI) { const int nbk = 2 * DFF / 32, kb = r / nbk, nb = r % nbk; p0_transpose_item(F.w_fi, DM, 2 * DFF, WFI, map_fi(32 * nb), scr, kb, nb, F.lane); continue; } r -= I_FI;
        { const int kb = r / 32, nb = r % 32; p0_transpose_item(F.w_fo, DFF, DM, WFO, 32 * nb, scr, kb, nb, F.lane); }
    }
    for (int k = 0; k < 8; ++k) { const int m = 2048 * F.xcc + F.tk * 8 + F.wave + 256 * k; rms_row_to_bf16(F.x + (size_t)m * DM, F.g_pre, XN + (size_t)m * DM, F.lane); }
}

__device__ __forceinline__ void scores_phase(Frame& F0) {
    Frame F = F0; F.tid = opaque((int)threadIdx.x); F.lane = F.tid & 63; F.wave = __builtin_amdgcn_readfirstlane(F.tid >> 6);
    const bf16* RQ = (const bf16*)(F.ws + WS_RQ); const bf16* RK = (const bf16*)(F.ws + WS_RK); bf16* PB = (bf16*)(F.ws + WS_PB);
    const int w = F.wave, r = F.lane & 31, hh = F.lane >> 5;
    for (int li = 0; li < 2; ++li) { const int lu = F.tk + 32 * li;
        const int h = lu & 3, b = F.xcc >> 2, nn = 16 * (F.xcc & 3) + (lu >> 2), bh = b * 4 + h, uid = bh * 64 + nn; const int m0 = b * T + 128 * nn;
        const int cb = w >> 1, sh = w & 1;
        const bf16* qp = RQ + (size_t)(m0 + 32 * cb + r) * DM + h * 256 + 8 * hh;
        bf16x8 af[16];
#pragma unroll
        for (int ks = 0; ks < 16; ++ks) af[ks] = *(const bf16x8*)(qp + 16 * ks);
        bf16* pout = PB + (size_t)uid * 16384;
#pragma unroll
        for (int jj = 0; jj < 2; ++jj) { const int sb = 2 * sh + jj; f32x16 acc;
#pragma unroll
            for (int i = 0; i < 16; ++i) acc[i] = 0.f;
            if (sb <= cb) { const bf16* kp = RK + (size_t)(m0 + 32 * sb + r) * DM + h * 256 + 8 * hh;
#pragma unroll
                for (int ks = 0; ks < 16; ++ks) { const bf16x8 bfr = *(const bf16x8*)(kp + 16 * ks); acc = MFMA32(af[ks], bfr, acc); } }
#pragma unroll
            for (int i = 0; i < 16; ++i) { const int c = 32 * cb + crow(i, hh), s = 32 * sb + r; const float v = (s <= c) ? acc[i] : 0.f; pout[c * 128 + s] = (bf16)f2bf(v); }
        }
    }
}

__device__ __forceinline__ void scan_phase(Frame& F0) {
    Frame F = F0; F.tid = opaque((int)threadIdx.x); F.lane = F.tid & 63; F.wave = __builtin_amdgcn_readfirstlane(F.tid >> 6);
    if (F.tk >= 8) return;
    const int bh = F.xcc, b = bh >> 2, h = bh & 3, es = F.tk;
    const int w = F.wave, lane = F.lane, r = lane & 31, hh = lane >> 5, tid = F.tid;
    const int i16 = lane & 15, q4 = i16 >> 2, p4 = i16 & 3, blk = (lane >> 4) & 1;
    constexpr int KP = 528, VP = 144;
    LAS unsigned char* KT = F.lds;
    LAS unsigned char* VL = F.lds + 128 * KP;
    LAS unsigned char* ST = VL + 128 * VP;
    const bf16* RQ = (const bf16*)(F.ws + WS_RQ); const bf16* RK = (const bf16*)(F.ws + WS_RK); const bf16* PB = (const bf16*)(F.ws + WS_PB);
    bf16* YR = (bf16*)(F.ws + WS_YR); const float* MP = (const float*)(F.ws + WS_MP);
    const float g = 1.f - exp2f(-(float)(5 + h)); const float lg2 = log2f(g);
    const float gamma = exp2f(lg2 * 128.f), c127 = exp2f(lg2 * 127.f);
    f32x16 st[2];
    {
        LAS float* km = (LAS float*)F.lds; LAS float* vm = km + 16 * 256;
        for (int idx = tid; idx < 16 * 128; idx += 512) { const int i = idx >> 7, d = idx & 127;
            const float x1 = MP[i * 5120 + h * 256 + d], x2 = MP[i * 5120 + h * 256 + d + 128];
            const float rev = __builtin_amdgcn_fractf((float)i * __builtin_amdgcn_exp2f(-(float)d * ROPE_C) * INV_2PI);
            const float sn = __builtin_amdgcn_sinf(rev), cs = __builtin_amdgcn_cosf(rev), sc = exp2f(lg2 * (float)(15 - i));
            km[i * 256 + d] = (x1 * cs - x2 * sn) * sc; km[i * 256 + d + 128] = (x1 * sn + x2 * cs) * sc; }
        for (int idx = tid; idx < 16 * 64; idx += 512) { const int i = idx >> 6, e = idx & 63; vm[i * 64 + e] = MP[i * 5120 + 1024 + h * 512 + 64 * es + e]; }
        __syncthreads();
#pragma unroll
        for (int et = 0; et < 2; ++et)
#pragma unroll
            for (int reg = 0; reg < 16; ++reg) st[et][reg] = 0.f;
#pragma unroll 1
        for (int i = 0; i < 16; ++i) {
#pragma unroll
            for (int et = 0; et < 2; ++et) { const float vv = vm[i * 64 + 32 * et + r];
#pragma unroll
                for (int reg = 0; reg < 16; ++reg) st[et][reg] += km[i * 256 + 32 * w + crow(reg, hh)] * vv; } }
        __syncthreads();
    }
    v4u kreg[8], vreg[2];
#define SCAN_LOAD(nn_) do { const int m0_ = b * T + 128 * (nn_); \
        _Pragma("unroll") for (int i = 0; i < 8; ++i) { const int q = i * 512 + tid, row = q >> 5, ch = q & 31; kreg[i] = *(const v4u*)(RK + (size_t)(m0_ + row) * DM + h * 256 + ch * 8); } \
        _Pragma("unroll") for (int i = 0; i < 2; ++i) { const int q = i * 512 + tid, row = q >> 3, ch = q & 7; vreg[i] = *(const v4u*)(YR + (size_t)(m0_ + row) * 2048 + h * 512 + 64 * es + ch * 8); } } while (0)
    SCAN_LOAD(0);
    const int cb = w >> 1, et = w & 1;
    for (int nn = 0; nn < 64; ++nn) {
        const int m0 = b * T + 128 * nn; const int uid = bh * 64 + nn;
#pragma unroll
        for (int i = 0; i < 8; ++i) { const int q = i * 512 + tid, row = q >> 5, ch = q & 31; *(LAS v4u*)(KT + row * KP + ch * 16) = kreg[i]; }
#pragma unroll
        for (int i = 0; i < 2; ++i) { const int q = i * 512 + tid, row = q >> 3, ch = q & 7; *(LAS v4u*)(VL + row * VP + ch * 16) = vreg[i]; }
#pragma unroll
        for (int e2 = 0; e2 < 2; ++e2)
#pragma unroll
            for (int gq = 0; gq < 4; ++gq) { u32x2v pv; pv.x = cvtpk_s(st[e2][4 * gq], st[e2][4 * gq + 1]); pv.y = cvtpk_s(st[e2][4 * gq + 2], st[e2][4 * gq + 3]);
                *(LAS u32x2v*)(ST + (32 * e2 + r) * KP + (32 * w + 8 * gq + 4 * hh) * 2) = pv; }
        __syncthreads();
        if (nn + 1 < 64) SCAN_LOAD(nn + 1);
        f32x16 aC, aI;
#pragma unroll
        for (int i = 0; i < 16; ++i) { aC[i] = 0.f; aI[i] = 0.f; }
        {
            const bf16* qp = RQ + (size_t)(m0 + 32 * cb + r) * DM + h * 256 + 8 * hh;
#pragma unroll
            for (int ks = 0; ks < 16; ++ks) { const bf16x8 A = *(const bf16x8*)(qp + 16 * ks); const bf16x8 B = *(const LAS bf16x8*)(ST + (32 * et + r) * KP + (16 * ks + 8 * hh) * 2); aC = MFMA32(A, B, aC); }
            const bf16* pp = PB + (size_t)uid * 16384 + (32 * cb + r) * 128 + 8 * hh;
#pragma unroll
            for (int ks = 0; ks < 8; ++ks) { const bf16x8 A = *(const bf16x8*)(pp + 16 * ks);
                const LAS unsigned char* vp = VL + (16 * ks + 8 * hh + q4) * VP + (32 * et + 16 * blk + 4 * p4) * 2;
                const bf16x8 B = cat8(tr_read(vp), tr_read(vp + 4 * VP)); aI = MFMA32(A, B, aI); }
        }
        f32x16 d0, d1;
#pragma unroll
        for (int i = 0; i < 16; ++i) { d0[i] = 0.f; d1[i] = 0.f; }
#pragma unroll
        for (int ks = 0; ks < 8; ++ks) {
            const LAS unsigned char* kp = KT + (16 * ks + 8 * hh + q4) * KP + (32 * w + 16 * blk + 4 * p4) * 2;
            const bf16x8 A = cat8(tr_read(kp), tr_read(kp + 4 * KP));
            const LAS unsigned char* vp = VL + (16 * ks + 8 * hh + q4) * VP + (16 * blk + 4 * p4) * 2;
            const bf16x8 B0 = cat8(tr_read(vp), tr_read(vp + 4 * VP)); const bf16x8 B1 = cat8(tr_read(vp + 64), tr_read(vp + 64 + 4 * VP));
            d0 = MFMA32(A, B0, d0); d1 = MFMA32(A, B1, d1); }
#pragma unroll
        for (int i = 0; i < 16; ++i) { st[0][i] = gamma * st[0][i] + c127 * d0[i]; st[1][i] = gamma * st[1][i] + c127 * d1[i]; }
        {
            bf16* yp = YR + (size_t)(m0 + 32 * cb) * 2048 + h * 512 + 64 * es + 32 * et + r;
#pragma unroll
            for (int i = 0; i < 16; ++i) yp[(size_t)crow(i, hh) * 2048] = (bf16)f2bf(g * aC[i] + aI[i]);
        }
        __syncthreads();
    }
#undef SCAN_LOAD
}

__device__ __forceinline__ void gnstats_phase(Frame& F0) {
    Frame F = F0; F.tid = opaque((int)threadIdx.x); F.lane = F.tid & 63; F.wave = __builtin_amdgcn_readfirstlane(F.tid >> 6);
    const bf16* YR = (const bf16*)(F.ws + WS_YR); f32x2v* GS = (f32x2v*)(F.ws + WS_GS);
    for (int k2 = 0; k2 < 32; ++k2) { const int it = (2048 * F.xcc + F.tk * 8 + F.wave + 256 * (k2 >> 2)) * 4 + (k2 & 3);
        const v4u yv = *(const v4u*)(YR + (size_t)it * 512 + F.lane * 8); float y[8]; unpack8(yv, y);
        float s = 0.f, q = 0.f;
#pragma unroll
        for (int i = 0; i < 8; ++i) { s += y[i]; q += y[i] * y[i]; }
        s = wave_sum(s); q = wave_sum(q);
        const float mean = s * (1.f / 512.f); float var = q * (1.f / 512.f) - mean * mean; var = var < 0.f ? 0.f : var;
        if (F.lane == 0) GS[it] = (f32x2v){mean, 1.f / sqrtf(var + GN_EPS)};
    }
}

__device__ __forceinline__ void sb_phase(Frame& F0) {
    Frame F = F0; F.tid = opaque((int)threadIdx.x); F.lane = F.tid & 63; F.wave = __builtin_amdgcn_readfirstlane(F.tid >> 6);
    const bf16* SQ = (const bf16*)(F.ws + WS_RQ); const bf16* SK = (const bf16*)F.out; const bf16* SV = (const bf16*)F.out + (size_t)M * DM; bf16* YS = (bf16*)(F.ws + WS_RQ); const bf16* MKV = (const bf16*)(F.ws + WS_MKV);
    constexpr int P = 144;
    LAS unsigned char* KL = F.lds; LAS unsigned char* VL = F.lds + 64 * P; LAS int* flags = (LAS int*)(F.lds + 2 * 64 * P);
    const int w = F.wave, lane = F.lane, r = lane & 31, hh = lane >> 5, tid = F.tid;
    const int i16 = lane & 15, q4 = i16 >> 2, p4 = i16 & 3, bk = (lane >> 4) & 1;
    const int row_l = tid >> 3, ch = tid & 7;
    for (int li = 0; li < 4; ++li) { const int lu = F.tk + 32 * li;
        const int h = lu & 15, b = F.xcc >> 2, qb = 8 * (F.xcc & 3) + (lu >> 4);
        const int t0w = 256 * qb + 32 * w;
        const bf16* qp = SQ + (size_t)(b * T + t0w + r) * DM + h * 64 + 8 * hh;
        bf16x8 qf[4];
#pragma unroll
        for (int d0 = 0; d0 < 4; ++d0) qf[d0] = *(const bf16x8*)(qp + 16 * d0);
        const int pq = NMETA + t0w + r;
        const int jtw = (t0w + 46) >> 6, jtop = (256 * qb + 224 + 46) >> 6;
        float run = 1.f; f32x16 o0, o1;
#pragma unroll
        for (int i = 0; i < 16; ++i) { o0[i] = 0.f; o1[i] = 0.f; }
        bool done = false;
        v4u kreg, vreg;
#define SB_LOAD(j_) do { int p_ = 64 * (j_) + row_l; p_ = p_ < LK ? p_ : LK - 1; const int hc_ = h * 64 + ch * 8; \
        const bf16* kp_ = p_ < NMETA ? MKV + (size_t)p_ * DM + hc_ : SK + (size_t)(b * T + p_ - NMETA) * DM + hc_; const bf16* vp_ = p_ < NMETA ? MKV + (size_t)(16 + p_) * DM + hc_ : SV + (size_t)(b * T + p_ - NMETA) * DM + hc_; \
        kreg = *(const v4u*)kp_; vreg = *(const v4u*)vp_; } while (0)
        SB_LOAD(jtop);
        for (int j = jtop; j >= 0; --j) {
            *(LAS v4u*)(KL + row_l * P + ch * 16) = kreg; *(LAS v4u*)(VL + row_l * P + ch * 16) = vreg;
            __syncthreads();
            if (j > 0) SB_LOAD(j - 1);
            if (!done && j <= jtw) {
                f32x16 p0, p1;
#pragma unroll
                for (int i = 0; i < 16; ++i) { p0[i] = 0.f; p1[i] = 0.f; }
#pragma unroll
                for (int d0 = 0; d0 < 4; ++d0) { const bf16x8 a0 = *(const LAS bf16x8*)(KL + r * P + (16 * d0 + 8 * hh) * 2); const bf16x8 a1 = *(const LAS bf16x8*)(KL + (32 + r) * P + (16 * d0 + 8 * hh) * 2);
                    p0 = MFMA32(a0, qf[d0], p0); p1 = MFMA32(a1, qf[d0], p1); }
                const bool need_mask = (64 * j + 63 >= NMETA + t0w);
#pragma unroll
                for (int bb = 1; bb >= 0; --bb) {
                    float ri[16], a[16];
#pragma unroll
                    for (int i = 0; i < 16; ++i) { const float zz = bb ? p1[i] : p0[i]; const int key = 64 * j + 32 * bb + crow(i, hh);
                        float e = __builtin_amdgcn_exp2f(fminf(zz, 126.f)); if (need_mask && key >= pq) e = 0.f;
                        ri[i] = __builtin_amdgcn_rcpf(1.f + e); a[i] = e * ri[i]; }
#pragma unroll
                    for (int gq = 3; gq >= 0; --gq) {
                        const float Gp = (ri[4 * gq] * ri[4 * gq + 1]) * (ri[4 * gq + 2] * ri[4 * gq + 3]); const float other = __shfl_xor(Gp, 32);
                        float t = hh == 0 ? run * other : run;
                        a[4 * gq + 3] *= t; t *= ri[4 * gq + 3]; a[4 * gq + 2] *= t; t *= ri[4 * gq + 2]; a[4 * gq + 1] *= t; t *= ri[4 * gq + 1]; a[4 * gq] *= t;
                        run = run * (Gp * other); }
#pragma unroll
                    for (int s = 0; s < 2; ++s) {
                        v4u pw; pw.x = cvtpk_s(a[8 * s], a[8 * s + 1]); pw.y = cvtpk_s(a[8 * s + 2], a[8 * s + 3]); pw.z = cvtpk_s(a[8 * s + 4], a[8 * s + 5]); pw.w = cvtpk_s(a[8 * s + 6], a[8 * s + 7]);
                        const bf16x8 A = __builtin_bit_cast(bf16x8, pw);
                        const LAS unsigned char* vp = VL + (32 * bb + 16 * s + 4 * hh + q4) * P + (16 * bk + 4 * p4) * 2;
                        const bf16x8 B0 = cat8(tr_read(vp), tr_read(vp + 8 * P)); const bf16x8 B1 = cat8(tr_read(vp + 64), tr_read(vp + 64 + 8 * P));
                        o0 = MFMA32(A, B0, o0); o1 = MFMA32(A, B1, o1); }
                }
                done = __all(run < 7.8886090522101181e-31f) != 0;
            }
            if (lane == 0) flags[w] = done ? 1 : 0;
            __syncthreads();
            bool all = true;
#pragma unroll
            for (int k = 0; k < 8; ++k) all = all && (flags[k] != 0);
            if (all) break;
        }
#undef SB_LOAD
        bf16* op = YS + (size_t)(b * T + t0w) * DM + h * 64 + r;
#pragma unroll
        for (int i = 0; i < 16; ++i) { bf16* rp = op + (size_t)crow(i, hh) * DM; rp[0] = (bf16)f2bf(o0[i]); rp[32] = (bf16)f2bf(o1[i]); }
    }
}

__device__ __forceinline__ void p7b_phase(Frame& F0) {
    Frame F = F0; F.tid = opaque((int)threadIdx.x); F.lane = F.tid & 63; F.wave = __builtin_amdgcn_readfirstlane(F.tid >> 6);
    bf16* HN2 = (bf16*)(F.ws + WS_HN2);
    for (int k = 0; k < 8; ++k) { const int m = 2048 * F.xcc + F.tk * 8 + F.wave + 256 * k;
        GAS f32x4* mr = (GAS f32x4*)(F.out + (size_t)m * DM) + F.lane; const GAS f32x4* mi = (const GAS f32x4*)((const float*)(F.ws + WS_FF) + (size_t)m * DM) + F.lane; const GAS f32x4* xr = (const GAS f32x4*)(F.x + (size_t)m * DM) + F.lane;
        const GAS f32x4* g1 = (const GAS f32x4*)F.g_post + F.lane; const GAS f32x4* g2 = (const GAS f32x4*)F.g_fpre + F.lane;
        f32x4 v[4]; float s = 0.f;
#pragma unroll
        for (int j = 0; j < 4; ++j) { v[j] = mr[64 * j]; s += (v[j].x * v[j].x + v[j].y * v[j].y) + (v[j].z * v[j].z + v[j].w * v[j].w); }
        const float rs = 1.f / sqrtf(wave_sum(s) * (1.f / DM) + NORM_EPS); float s2 = 0.f;
#pragma unroll
        for (int j = 0; j < 4; ++j) { v[j] = xr[64 * j] + v[j] * rs * g1[64 * j]; mr[64 * j] = v[j]; s2 += (v[j].x * v[j].x + v[j].y * v[j].y) + (v[j].z * v[j].z + v[j].w * v[j].w); }
        const float rs2 = 1.f / sqrtf(wave_sum(s2) * (1.f / DM) + NORM_EPS);
        GAS unsigned long long* o8 = (GAS unsigned long long*)(HN2 + (size_t)m * DM) + F.lane;
#pragma unroll
        for (int j = 0; j < 4; ++j) { const f32x4 g = g2[64 * j]; o8[64 * j] = (unsigned long long)pk2(v[j].x * rs2 * g.x, v[j].y * rs2 * g.y) | ((unsigned long long)pk2(v[j].z * rs2 * g.z, v[j].w * rs2 * g.w) << 32); }
    }
}
__device__ __forceinline__ void p9b_phase(Frame& F0) {
    Frame F = F0; F.tid = opaque((int)threadIdx.x); F.lane = F.tid & 63; F.wave = __builtin_amdgcn_readfirstlane(F.tid >> 6);
    const float* FFb = (const float*)(F.ws + WS_FF);
    for (int k = 0; k < 8; ++k) { const int m = 2048 * F.xcc + F.tk * 8 + F.wave + 256 * k;
        GAS f32x4* hr = (GAS f32x4*)(F.out + (size_t)m * DM) + F.lane; const GAS f32x4* fr = (const GAS f32x4*)(FFb + (size_t)m * DM) + F.lane;
        const GAS f32x4* g3 = (const GAS f32x4*)F.g_fpost + F.lane;
        f32x4 v[4]; float s = 0.f;
#pragma unroll
        for (int j = 0; j < 4; ++j) { v[j] = fr[64 * j]; s += (v[j].x * v[j].x + v[j].y * v[j].y) + (v[j].z * v[j].z + v[j].w * v[j].w); }
        const float rs = 1.f / sqrtf(wave_sum(s) * (1.f / DM) + NORM_EPS);
#pragma unroll
        for (int j = 0; j < 4; ++j) hr[64 * j] = hr[64 * j] + v[j] * rs * g3[64 * j];
    }
}


#ifndef DEBUG_STOP
#define DEBUG_STOP 0
#endif
#ifndef DEBUG_CMODE
#define DEBUG_CMODE 0
#endif
__device__ __forceinline__ void dbg_dump(Frame& F, const bf16* b0, int ld0, const bf16* b1, int ld1, const bf16* b2, int ld2, const bf16* b3, int ld3) {
    const int tid = threadIdx.x;
    for (int e0 = F.tk * 512 + tid; e0 < 2048 * DM; e0 += 32 * 512) { const int m = 2048 * F.xcc + (e0 >> 10), c = e0 & 1023; const size_t e = (size_t)m * DM + c; float v = 0.f;
#ifndef DEBUG_CLAMP
#define DEBUG_CLAMP 1e30f
#endif
#define DCL(x) fminf(fmaxf((x), -DEBUG_CLAMP), DEBUG_CLAMP)
        if (b0) v += DCL(bf2f(b0[(size_t)m * ld0 + c])); if (b1) v += DCL(bf2f(b1[(size_t)m * ld1 + c])); if (b2) v += DCL(bf2f(b2[(size_t)m * ld2 + c])); if (b3) v += DCL(bf2f(b3[(size_t)m * ld3 + c]));
        F.out[e] = v; }
}

__device__ __forceinline__ void dbg_maxloc(Frame& F, XcdBarrier& bar, const bf16* buf, int ld, int ncols) {
    gu32* slot = F.ctl + 2048;
    const int tid = threadIdx.x; const int gt = F.vcu * 512 + tid, NGT = F.G * 512; float mx = 0.f; int mrow = 0;
#if defined(DEBUG_SC1)
    for (size_t e = gt; e < (size_t)M * ncols / 2; e += NGT) { const int m = (int)(e / (ncols / 2)), c = 2 * (int)(e % (ncols / 2)); const unsigned w2 = __hip_atomic_load((const unsigned*)(buf + (size_t)m * ld + c), __ATOMIC_RELAXED, __HIP_MEMORY_SCOPE_SYSTEM);
        const float v = fmaxf(fabsf(__uint_as_float(w2 << 16)), fabsf(__uint_as_float(w2 & 0xffff0000u))); if (v > mx) { mx = v; mrow = m; } }
#else
    for (int e0 = F.tk * 512 + tid; e0 < 2048 * ncols; e0 += 32 * 512) { const int m = 2048 * F.xcc + e0 / ncols, c = e0 % ncols; const float v = fabsf(bf2f(buf[(size_t)m * ld + c])); if (v > mx) { mx = v; mrow = m; } }
#endif
    atomicMax((unsigned*)slot, __float_as_uint(mx));
    xcd_barrier(bar);
    const unsigned gm = __hip_atomic_load(slot, __ATOMIC_RELAXED, __HIP_MEMORY_SCOPE_AGENT);
    if (__float_as_uint(mx) == gm && gm != 0u) __hip_atomic_store(slot + 1, (unsigned)mrow, __ATOMIC_RELAXED, __HIP_MEMORY_SCOPE_AGENT);
    xcd_barrier(bar);
    const float gmax = __uint_as_float(gm); const float grow = (float)__hip_atomic_load(slot + 1, __ATOMIC_RELAXED, __HIP_MEMORY_SCOPE_AGENT);
#ifndef DEBUG_ROWDIV
#define DEBUG_ROWDIV 16.0f
#endif
#if defined(DEBUG_ROWMODE)
    const float k1 = 10.f * grow, k2 = k1;
#else
    const float k1 = 100.f * gmax, k2 = k1;
#endif
    for (size_t e = gt; e < (size_t)M * DM; e += NGT) F.out[e] = (e < (size_t)M * DM / 2) ? k1 : k2;
}

__device__ __forceinline__ void dbg_check_gate(Frame& F, XcdBarrier& bar, const bf16* XN, const bf16* W, const bf16* G, int mode, int ldg = DM, bool ident = false) {
    gu32* slot = F.ctl + 2048;
    const int tid = threadIdx.x; unsigned cnt = 0u; unsigned best = 0u; unsigned bcol = 0u;
    for (int e0 = F.tk * 512 + tid; e0 < 2048 * 16; e0 += 32 * 512) { const int m = 2048 * F.xcc + (e0 >> 4), c = (e0 & 15) * 64 + ((e0 >> 4) & 63);
        float acc = 0.f; const bf16* xr = XN + (size_t)m * DM; const bf16* wr = W + (size_t)c * DM;
        for (int k = 0; k < DM; ++k) acc += bf2f(xr[k]) * bf2f(wr[k]);
        const float ref = ident ? acc : 1.f / (1.f + expf(-acc)); const float got = bf2f(G[(size_t)m * ldg + c]);
        if (!(fabsf(got - ref) < 0.02f + 0.01f * fabsf(ref))) { ++cnt; const unsigned key = 0x7fffffffu - (unsigned)m; if (key > best) { best = key; bcol = (unsigned)c; } } }
    atomicAdd((unsigned*)slot, cnt); atomicMax((unsigned*)slot + 1, best);
    xcd_barrier(bar);
    const unsigned gb = __hip_atomic_load(slot + 1, RLX_AGENT);
    if (best == gb && gb != 0u) __hip_atomic_store(slot + 2, bcol, RLX_AGENT);
    xcd_barrier(bar);
    const float total = (float)__hip_atomic_load(slot, RLX_AGENT); const float minrow = gb ? (float)(0x7fffffffu - gb) : -1.f; const float col = (float)__hip_atomic_load(slot + 2, RLX_AGENT);
    float bucket = 0.f; { float t = total; while (t >= 1.f) { bucket += 1.f; t *= 0.0625f; } }
    const float k = mode == 0 ? 1000.f * bucket : (mode == 1 ? 10.f * (minrow + 1.f) : 100.f * (col + 1.f));
    for (size_t e = (size_t)blockIdx.x * 512 + tid; e < (size_t)M * DM; e += (size_t)gridDim.x * 512) F.out[e] = k;
}

__device__ __forceinline__ void dbg_check_w(Frame& F, XcdBarrier& bar, const bf16* WT, int row0, int orig0, int nrows) {
    gu32* slot = F.ctl + 2048; const int tid = threadIdx.x; unsigned cnt = 0u;
    for (int e = F.vcu * 512 + tid; e < nrows * 64; e += F.G * 512) { const int r = e >> 6, k = ((e & 63) * 16 + (r & 15)) & 1023;
        const unsigned want = f2bf(F.w_in[(size_t)k * PW + orig0 + r]); const unsigned got = WT[(size_t)(row0 + r) * DM + k];
        if (want != got) ++cnt; }
    atomicAdd((unsigned*)slot, cnt);
    xcd_barrier(bar);
    const float total = (float)__hip_atomic_load(slot, RLX_AGENT);
    float bucket = 0.f; { float t = total; while (t >= 1.f) { bucket += 1.f; t *= 0.0625f; } }
    const float k = 1000.f * bucket;
    for (size_t e = (size_t)blockIdx.x * 512 + tid; e < (size_t)M * DM; e += (size_t)gridDim.x * 512) F.out[e] = k;
}
struct Args { const float* in[12]; float* out; unsigned char* ws; };
#ifndef PHM
#define PHM 0xFFFFF
#endif
#define PH(k) ((PHM >> (k)) & 1)
#ifndef PG8_SP2
#define PG8_SP2 true
#endif
#ifndef PG8_ALIGN
#define PG8_ALIGN true
#endif
__global__ void __launch_bounds__(NWAVES * 64, 2) mk_fwd(Args args) {
    extern __shared__ __attribute__((aligned(16))) unsigned char lds[];
    Frame F;
    F.lds = (LAS unsigned char*)lds;
    F.MISC = (volatile LAS unsigned*)(F.lds + MISC_OFF);
    F.tid = 0; F.lane = 0; F.wave = 0;
    F.G = gridDim.x; { const int bx = blockIdx.x; F.vcu = (F.G % 8 == 0) ? (bx % 8) * (F.G / 8) + bx / 8 : bx; }
    unsigned char* ws = args.ws; F.ws = ws;
    F.ctl = (gu32*)(ws + WS_CTL);
    F.x = args.in[0]; F.meta = args.in[1]; F.w_in = args.in[2]; F.w_ro = args.in[3]; F.w_so = args.in[4]; F.w_out = args.in[5]; F.w_fi = args.in[6]; F.w_fo = args.in[7];
    F.g_pre = args.in[8]; F.g_post = args.in[9]; F.g_fpre = args.in[10]; F.g_fpost = args.in[11]; F.out = args.out;
    for (int u = threadIdx.x; u < (LDS_BYTES - LDSCTL_OFF) / 4; u += NWAVES * 64) ((LAS unsigned*)(F.lds + LDSCTL_OFF))[u] = 0u;
    __syncthreads();
    XcdBarrier bar = xcd_barrier_post((unsigned*)(F.ctl + CW_BAR), F.MISC + 8);
    if (threadIdx.x == 0) { const unsigned x = xb_xcc_id() & 7u; const unsigned t = __hip_atomic_fetch_add(F.ctl + CW_TICKET + 64 * x, 1u, RLX_AGENT);
        if (t >= 32u) __hip_atomic_store(F.ctl + CW_BAD, 1u, RLX_AGENT);
        F.MISC[16] = x; F.MISC[17] = t & 31u; }
    __syncthreads();
    F.xcc = (int)F.MISC[16]; F.tk = (int)F.MISC[17]; F.cg = F.tk * 8 + F.xcc; F.vcu = F.xcc * 32 + F.tk;
#define GRID_BAR() xcd_barrier(bar)
    bf16* WIN = (bf16*)(ws + WS_WIN); bf16* XN = (bf16*)(ws + WS_XN);

    if (DEBUG_STOP == 20) {
        GRID_BAR();
        unsigned mx = 0u, npop = 0u;
        for (int x = 0; x < 8; ++x) { const unsigned c = __hip_atomic_load(F.ctl + CW_TICKET + 64 * x, RLX_AGENT); mx = c > mx ? c : mx; npop += c > 0u ? 1u : 0u; }
        const float k1 = 1000.f * (float)mx, k2 = 100.f * (float)npop;
        for (size_t e = (size_t)blockIdx.x * 512 + threadIdx.x; e < (size_t)M * DM; e += (size_t)gridDim.x * 512) F.out[e] = (e < (size_t)M * DM / 2) ? k1 : k2;
        return;
    }
#if defined(DEBUG_FILL)
    {
        const size_t n16 = (WS_END - CTL_ZERO_BYTES) / 16; v4u* p16 = (v4u*)(ws + CTL_ZERO_BYTES); const v4u z = {DEBUG_FILL, DEBUG_FILL, DEBUG_FILL, DEBUG_FILL};
        for (size_t i = (size_t)blockIdx.x * 512 + threadIdx.x; i < n16; i += (size_t)gridDim.x * 512) p16[i] = z;
        GRID_BAR();
    }
#endif
    if (PH(0)) p0_prologue(F); GRID_BAR();
    if (PH(1)) { pg8::Gemm g{XN, WIN, M, 4096, DM}; pg8::StaticOrder S; S.init(M, 4096, F.G, F.cg);
      EpiP1 E{(bf16*)(ws + WS_RQ), (bf16*)(ws + WS_RK), (bf16*)(ws + WS_YR)};
      pg8::gemm_phase<EpiP1, pg8::StaticOrder, PG8_ALIGN, PG8_SP2>(F.lds, g, S, E); }
    GRID_BAR();
    if (DEBUG_STOP == 54) { dbg_check_w(F, bar, WIN, 9216, 9216, 2048); return; }
    if (DEBUG_STOP == 55) { dbg_check_w(F, bar, WIN, 0, 0, 4096); return; }
    if (DEBUG_STOP == 53) {
        { pg8::Gemm g{XN, WIN + (size_t)9216 * DM, M, 2048, DM}; pg8::StaticOrder S; S.init(M, 2048, F.G, F.cg);
          EpiSig E{(bf16*)(ws + WS_GB), (bf16*)(ws + WS_GA)};
          pg8::gemm_phase<EpiSig, pg8::StaticOrder, PG8_ALIGN, PG8_SP2>(F.lds, g, S, E); }
        GRID_BAR();
#if defined(DEBUG_SIGID)
        dbg_check_gate(F, bar, XN, WIN + (size_t)9216 * DM, (const bf16*)(ws + WS_GB), DEBUG_CMODE, DM, true); return; }
#else
        dbg_check_gate(F, bar, XN, WIN + (size_t)9216 * DM, (const bf16*)(ws + WS_GB), DEBUG_CMODE); return; }
#endif
    if (DEBUG_STOP == 52) { dbg_check_gate(F, bar, XN, WIN + (size_t)2048 * DM, (const bf16*)(ws + WS_YR), DEBUG_CMODE, 2048, true); return; }
    if (DEBUG_STOP == 1) { dbg_dump(F, (const bf16*)(ws + WS_RQ), DM, (const bf16*)(ws + WS_RK), DM, (const bf16*)(ws + WS_YR), 2048, (const bf16*)(ws + WS_YR) + 1024, 2048); return; }
    if (PH(2)) scores_phase(F); GRID_BAR();
    if (DEBUG_STOP == 8) { dbg_dump(F, (const bf16*)(ws + WS_PB), 512, nullptr, 0, nullptr, 0, nullptr, 0); return; }
    if (PH(3)) scan_phase(F); GRID_BAR();
    if (DEBUG_STOP == 12) { dbg_maxloc(F, bar, (const bf16*)(ws + WS_YR), 2048, 2048); return; }
    if (DEBUG_STOP == 2) { dbg_dump(F, (const bf16*)(ws + WS_YR), 2048, (const bf16*)(ws + WS_YR) + 1024, 2048, nullptr, 0, nullptr, 0); return; }
    if (PH(4)) gnstats_phase(F);
    if (PH(5)) { pg8::Gemm g{XN, WIN + (size_t)4096 * DM, M, 3072, DM}; pg8::StaticOrder S; S.init(M, 3072, F.G, F.cg);
      EpiP3 E{(bf16*)(ws + WS_RQ), (bf16*)F.out, (bf16*)F.out + (size_t)M * DM};
      pg8::gemm_phase<EpiP3, pg8::StaticOrder, PG8_ALIGN, PG8_SP2>(F.lds, g, S, E); }
    GRID_BAR();
    if (PH(6)) sb_phase(F); GRID_BAR();
    if (DEBUG_STOP == 3) { dbg_dump(F, (const bf16*)(ws + WS_RQ), DM, nullptr, 0, nullptr, 0, nullptr, 0); return; }
    if (PH(7)) { pg8::Gemm g{XN, WIN + (size_t)7168 * DM, M, 2048, DM}; pg8::StaticOrder S; S.init(M, 2048, F.G, F.cg);
      EpiRG E{(bf16*)(ws + WS_YR), (const f32x2v*)(ws + WS_GS)};
      pg8::gemm_phase<EpiRG, pg8::StaticOrder, PG8_ALIGN, PG8_SP2>(F.lds, g, S, E); }
    if (PH(7)) { pg8::Gemm g{XN, WIN + (size_t)9216 * DM, M, 2048, DM}; pg8::StaticOrder S; S.init(M, 2048, F.G, F.cg);
      EpiSig E{(bf16*)(ws + WS_GA), (bf16*)(ws + WS_GB)};
      pg8::gemm_phase<EpiSig, pg8::StaticOrder, PG8_ALIGN, PG8_SP2>(F.lds, g, S, E); }
    GRID_BAR();
    if (DEBUG_STOP == 14) { dbg_maxloc(F, bar, (const bf16*)(ws + WS_YR), 2048, 2048); return; }
    if (DEBUG_STOP == 15) { dbg_maxloc(F, bar, (const bf16*)(ws + WS_GA), DM, DM); return; }
    if (DEBUG_STOP == 16) { dbg_maxloc(F, bar, (const bf16*)(ws + WS_GB), DM, DM); return; }
    if (DEBUG_STOP == 50) { dbg_check_gate(F, bar, XN, WIN + (size_t)9216 * DM, (const bf16*)(ws + WS_GA), DEBUG_CMODE); return; }
    if (DEBUG_STOP == 51) { dbg_check_gate(F, bar, XN, WIN + (size_t)10240 * DM, (const bf16*)(ws + WS_GB), DEBUG_CMODE); return; }
    if (DEBUG_STOP == 43) { dbg_dump(F, (const bf16*)(ws + WS_GA), DM, nullptr, 0, nullptr, 0, nullptr, 0); return; }
    if (DEBUG_STOP == 44) { dbg_dump(F, (const bf16*)(ws + WS_GB), DM, nullptr, 0, nullptr, 0, nullptr, 0); return; }
    if (DEBUG_STOP == 41) { dbg_dump(F, (const bf16*)(ws + WS_GA), DM, (const bf16*)(ws + WS_GB), DM, nullptr, 0, nullptr, 0); return; }
    if (DEBUG_STOP == 42) { dbg_dump(F, (const bf16*)(ws + WS_YR), 2048, (const bf16*)(ws + WS_YR) + 1024, 2048, nullptr, 0, nullptr, 0); return; }
    if (DEBUG_STOP == 4) { dbg_dump(F, (const bf16*)(ws + WS_GA), DM, (const bf16*)(ws + WS_GB), DM, (const bf16*)(ws + WS_YR), 2048, (const bf16*)(ws + WS_YR) + 1024, 2048); return; }
    if (PH(8)) { pg8::Gemm g{(const bf16*)(ws + WS_YR), (const bf16*)(ws + WS_WRO), M, DM, 2048}; pg8::StaticOrder S; S.init(M, DM, F.G, F.cg);
      EpiP6<false> E{(bf16*)(ws + WS_MG), (const bf16*)(ws + WS_GA)};
      pg8::gemm_phase<EpiP6<false>, pg8::StaticOrder, PG8_ALIGN, PG8_SP2>(F.lds, g, S, E); }
    if (PH(9)) { pg8::Gemm g{(const bf16*)(ws + WS_RQ), (const bf16*)(ws + WS_WSO), M, DM, DM}; pg8::StaticOrder S; S.init(M, DM, F.G, F.cg);
      EpiP6<true> E{(bf16*)(ws + WS_MG), (const bf16*)(ws + WS_GB)};
      pg8::gemm_phase<EpiP6<true>, pg8::StaticOrder, PG8_ALIGN, PG8_SP2>(F.lds, g, S, E); }
    GRID_BAR();
    if (DEBUG_STOP == 5) { dbg_dump(F, (const bf16*)(ws + WS_MG), DM, nullptr, 0, nullptr, 0, nullptr, 0); return; }
#if defined(DEBUG_COPYMG)
    {
        const v4u* src = (const v4u*)(ws + WS_MG); v4u* dst = (v4u*)(ws + WS_RQ); const size_t n16 = (size_t)M * DM * 2 / 16;
        for (size_t i = (size_t)blockIdx.x * 512 + threadIdx.x; i < n16; i += (size_t)gridDim.x * 512) dst[i] = src[i];
        GRID_BAR();
    }
#define DEBUG_P7A WS_RQ
#endif
#ifndef DEBUG_P7A
#define DEBUG_P7A WS_MG
#endif
    if (PH(10)) { pg8::Gemm g{(const bf16*)(ws + DEBUG_P7A), (const bf16*)(ws + WS_WOUT), M, DM, DM}; pg8::StaticOrder S; S.init(M, DM, F.G, F.cg);
      EpiF32 E{F.out, DM};
      pg8::gemm_phase<EpiF32, pg8::StaticOrder, PG8_ALIGN, PG8_SP2>(F.lds, g, S, E); }
    GRID_BAR();
    if (DEBUG_STOP == 7) return;
    if (PH(11)) p7b_phase(F); GRID_BAR();
    if (DEBUG_STOP == 6) return;
    if (PH(12)) { pg8::Gemm g{(const bf16*)(ws + WS_HN2), (const bf16*)(ws + WS_WFI), M, 2 * DFF, DM}; pg8::StaticOrder S; S.init(M, 2 * DFF, F.G, F.cg);
      EpiP8 E{(bf16*)(ws + WS_ACT)};
      pg8::gemm_phase<EpiP8, pg8::StaticOrder, PG8_ALIGN, PG8_SP2>(F.lds, g, S, E); }
    GRID_BAR();
    if (PH(13)) { pg8::Gemm g{(const bf16*)(ws + WS_ACT), (const bf16*)(ws + WS_WFO), M, DM, DFF}; pg8::StaticOrder S; S.init(M, DM, F.G, F.cg);
      EpiF32 E{(float*)(ws + WS_FF), DM};
      pg8::gemm_phase<EpiF32, pg8::StaticOrder, PG8_ALIGN, PG8_SP2>(F.lds, g, S, E); }
    GRID_BAR();
    if (PH(14)) p9b_phase(F);
    if (xb_ld(&bar.bar[XB_TMO]) != 0u || __hip_atomic_load(F.ctl + CW_BAD, RLX_AGENT) != 0u) {
        const int tid = threadIdx.x, lane = tid & 63, wave = tid >> 6; const float qn = __builtin_nanf("");
        for (int k = 0; k < 8; ++k) { const int m = 2048 * F.xcc + F.tk * 8 + wave + 256 * k; GAS f32x4* o = (GAS f32x4*)(F.out + (size_t)m * DM) + lane;
#pragma unroll
            for (int j = 0; j < 4; ++j) o[64 * j] = (f32x4){qn, qn, qn, qn}; }
    }
#undef GRID_BAR
}

extern "C" void kernel_launch(void* const* d_in, const int* in_sizes, int n_in, void* d_out, int out_size, void* d_ws, size_t ws_size, hipStream_t stream) {
    static int grid = 0;
    if (grid == 0) {
        if (n_in != 12 || in_sizes[0] != M * DM || out_size != M * DM || ws_size < WS_END) { fprintf(stderr, "kernel_launch: unexpected shapes (n_in %d, in0 %d, out %d, ws %zu); nothing launched\n", n_in, n_in > 0 ? in_sizes[0] : -1, out_size, ws_size); grid = -1; return; }
        int dev = 0, cus = 0, per_cu = 0;
        if (hipGetDevice(&dev) != hipSuccess || hipDeviceGetAttribute(&cus, hipDeviceAttributeMultiprocessorCount, dev) != hipSuccess) { grid = -1; return; }
        if (hipFuncSetAttribute((const void*)mk_fwd, hipFuncAttributeMaxDynamicSharedMemorySize, LDS_BYTES) != hipSuccess) { fprintf(stderr, "kernel_launch: hipFuncSetAttribute failed\n"); grid = -1; return; }
        if (hipOccupancyMaxActiveBlocksPerMultiprocessor(&per_cu, (const void*)mk_fwd, NWAVES * 64, LDS_BYTES) != hipSuccess || per_cu < 1) fprintf(stderr, "kernel_launch: occupancy query reports %d\n", per_cu);
        (void)hipGetLastError();
        grid = cus;
        if (grid != 256) { fprintf(stderr, "kernel_launch: built for a 256-CU device, found %d CUs; nothing launched\n", cus); grid = -1; return; }
    }
    if (grid < 0) return;
    if (hipMemsetAsync((char*)d_ws + WS_CTL, 0, CTL_ZERO_BYTES, stream) != hipSuccess) return;
    Args a{};
    for (int i = 0; i < 12; ++i) a.in[i] = (const float*)d_in[i];
    a.out = (float*)d_out; a.ws = (unsigned char*)d_ws;
    hipLaunchKernelGGL(mk_fwd, dim3(grid), dim3(NWAVES * 64), LDS_BYTES, stream, a);
}
```

```cpp
#include <hip/hip_runtime.h>
#include <cstdio>
#include <cstdint>
namespace pg8 {
#define PG8_LAS __attribute__((address_space(3)))
typedef unsigned short bf16_t;
typedef short bf16x8 __attribute__((ext_vector_type(8)));
typedef float f32x4 __attribute__((ext_vector_type(4)));
typedef unsigned u32x4 __attribute__((ext_vector_type(4)));
constexpr int BM = 256, BK = 64, HALF = 128, HTB = HALF * BK * 2  , STAGE_BYTES = 8 * HTB, NXCD = 8, WGM = 8;

__host__ __device__ __forceinline__ int lds_byte(int r, int c) { const int st = (r >> 4) * 2 + (c >> 5), rr = r & 15, cc = c & 31, ob = rr * 64 + cc * 2; return st * 1024 + (ob ^ (((ob >> 9) & 1) << 5)); }
__host__ __device__ __forceinline__ void stage_rc(int b, int& R, int& C) { const int st = b / 1024, sb = b % 1024, swz = sb ^ (((sb >> 9) & 1) << 5); R = (st >> 1) * 16 + swz / 64; C = (st & 1) * 32 + (swz % 64) / 2; }
__host__ __device__ __forceinline__ int perm32(int rho) { const int n = rho >> 4, i = rho & 15; return 8 * (i >> 2) + 4 * n + (i & 3); }

struct Unit { int pm, pn; };
struct Gemm { const bf16_t* A; const bf16_t* Bt; int M, N, K; };

struct StaticOrder {
    int nM, nN, nwg, G, c;
    __host__ __device__ void init(int M, int N, int G_, int c_) { nM = M / BM; nN = N / BM; nwg = nM * nN; G = G_; c = c_; }
    __host__ __device__ bool next(int i, Unit& u) const {
        const long L = (long)i * G + c; if (L >= nwg) return false;
        int wgid = (int)L; { const int q = nwg / NXCD, r = nwg % NXCD, xcd = wgid % NXCD, off = wgid / NXCD; wgid = (xcd < r ? xcd * (q + 1) : r * (q + 1) + (xcd - r) * q) + off; }
        const int nig = WGM * nN, gid = wgid / nig, fm = gid * WGM, gsz = (nM - fm) < WGM ? (nM - fm) : WGM;
        u.pm = fm + ((wgid % nig) % gsz); u.pn = (wgid % nig) / gsz; return true;
    }
    __device__ __forceinline__ void a_ready(const Unit&) const {}
    __device__ __forceinline__ void done(const Unit&) const {}
};

__device__ __forceinline__ unsigned cvt_pk_bf16(float lo, float hi) { unsigned r; asm volatile("v_cvt_pk_bf16_f32 %0, %1, %2" : "=v"(r) : "v"(lo), "v"(hi)); return r; }
typedef float f32x2 __attribute__((ext_vector_type(2)));
__device__ __forceinline__ f32x2 gelu_pk(f32x2 v) {
    const f32x2 av = __builtin_elementwise_abs(v), d = av * 0.2316418882f + 1.0f;
    f32x2 t; t.x = __builtin_amdgcn_rcpf(d.x); t.y = __builtin_amdgcn_rcpf(d.y);
    f32x2 q = t * 0.5307027145f + (-0.7265760135f); q = q * t + 0.7107068705f; q = q * t + (-0.142248368f); q = q * t + 0.127414796f; q = q * t;
    const f32x2 s = (v * v) * (-0.72134752044f);
    f32x2 e; e.x = __builtin_amdgcn_exp2f(s.x); e.y = __builtin_amdgcn_exp2f(s.y);
    const f32x2 m = v * (q * e), r = v - m;
    f32x2 o; o.x = v.x < 0.f ? m.x : r.x; o.y = v.y < 0.f ? m.y : r.y; return o;
}

template <int ACT  > struct EpiBf16 {
    static constexpr bool PERM = true, AFTER_DRAIN = false; static_assert(ACT == 0 || ACT == 1, "EpiBf16: ACT is 0 (none) or 1 (gelu_pk)");
    bf16_t* O; int ldc; const float* bias; int split_cols; size_t split_stride; float scale0;
    __device__ __forceinline__ void operator()(const f32x4 (&acc)[2][2][4][2], const Unit& u, int wr, int wc, int fr, int fq) const {
        const int row0 = u.pm * BM + wr * 64 + fr; int colt = u.pn * BM; bf16_t* base = O;
        float sc = 1.f; if (split_cols) { const int t = colt / split_cols; base += (size_t)t * split_stride; colt -= t * split_cols; if (t == 0) sc = scale0; }
        const int col0 = colt + wc * 32 + 8 * fq, bcol0 = u.pn * BM + wc * 32 + 8 * fq;
        f32x4 bv[2][2];
#pragma unroll
        for (int bj = 0; bj < 2; ++bj)
#pragma unroll
            for (int n = 0; n < 2; ++n) bv[bj][n] = bias ? *(const f32x4*)(bias + bcol0 + bj * HALF + 4 * n) : (f32x4){0.f, 0.f, 0.f, 0.f};
#pragma unroll
        for (int ai = 0; ai < 2; ++ai)
#pragma unroll
            for (int m = 0; m < 4; ++m) { bf16_t* rowp = base + (size_t)(row0 + ai * HALF + m * 16) * ldc + col0;
#pragma unroll
                for (int bj = 0; bj < 2; ++bj) { f32x4 v0 = acc[ai][bj][m][0] + bv[bj][0], v1 = acc[ai][bj][m][1] + bv[bj][1];
                    if (ACT == 1) { f32x2 a = gelu_pk((f32x2){v0[0], v0[1]}), b = gelu_pk((f32x2){v0[2], v0[3]}), c = gelu_pk((f32x2){v1[0], v1[1]}), d = gelu_pk((f32x2){v1[2], v1[3]});
                        v0 = (f32x4){a.x, a.y, b.x, b.y}; v1 = (f32x4){c.x, c.y, d.x, d.y}; }
                    v0 = v0 * sc; v1 = v1 * sc; u32x4 w; w.x = cvt_pk_bf16(v0[0], v0[1]); w.y = cvt_pk_bf16(v0[2], v0[3]); w.z = cvt_pk_bf16(v1[0], v1[1]); w.w = cvt_pk_bf16(v1[2], v1[3]);
                    *(u32x4*)(rowp + bj * HALF) = w; } }
    }
};

struct PanelStats {
    unsigned* xbuf;
    unsigned* cnt;
    unsigned* tmo;
    int ntn; float eps;
    unsigned code;
    __device__ __forceinline__ bool run(const f32x4 (&v)[2][2][4][2], const Unit& u, int wr, int wc, int fr, int fq, PG8_LAS unsigned char* lds, int wid, int lane) const {
        typedef float f32x2v __attribute__((ext_vector_type(2)));
        PG8_LAS f32x2v* P = (PG8_LAS f32x2v*)lds;
        PG8_LAS f32x2v* S = (PG8_LAS f32x2v*)(lds + 8192);
        PG8_LAS unsigned* flag = (PG8_LAS unsigned*)(lds + 8192 + 2048);
#pragma unroll
        for (int ai = 0; ai < 2; ++ai)
#pragma unroll
            for (int m = 0; m < 4; ++m) {
                float s = 0.f;
#pragma unroll
                for (int bj = 0; bj < 2; ++bj)
#pragma unroll
                    for (int n = 0; n < 2; ++n) { const f32x4 x = v[ai][bj][m][n]; s += (x[0] + x[1]) + (x[2] + x[3]); }
                s += __shfl_xor(s, 16); s += __shfl_xor(s, 32);
                const float mw = s * (1.0f / 64.0f); float q = 0.f;
#pragma unroll
                for (int bj = 0; bj < 2; ++bj)
#pragma unroll
                    for (int n = 0; n < 2; ++n) { const f32x4 d = v[ai][bj][m][n] - mw; q += (d[0] * d[0] + d[1] * d[1]) + (d[2] * d[2] + d[3] * d[3]); }
                q += __shfl_xor(q, 16); q += __shfl_xor(q, 32);
                if (fq == 0) P[(ai * HALF + wr * 64 + m * 16 + fr) * 4 + wc] = (f32x2v){mw, q};
            }
        asm volatile("s_waitcnt lgkmcnt(0)" ::: "memory"); __builtin_amdgcn_s_barrier(); asm volatile("" ::: "memory");
#if defined(BROKEN_EXCHANGE_NO_WAIT)
#warning BROKEN CONTROL BUILD: the row-statistics exchange does not wait; results are wrong by design
        if (blockIdx.x >= 64) { const long long t0_ = clock64(); while (clock64() - t0_ < 60000) __builtin_amdgcn_s_sleep(8); }
#endif
        const int row = wid * 32 + (lane & 31);
        if (lane < 32) {
            const f32x2v a = P[row * 4 + 0], b = P[row * 4 + 1], c = P[row * 4 + 2], d = P[row * 4 + 3];
            const float mt = (a.x + b.x + c.x + d.x) * 0.25f;
            const float da = a.x - mt, db = b.x - mt, dc = c.x - mt, dd = d.x - mt;
            const float m2 = (a.y + b.y) + (c.y + d.y) + 64.0f * ((da * da + db * db) + (dc * dc + dd * dd));
            unsigned long long* slot = (unsigned long long*)xbuf + ((size_t)(u.pm * BM + row) * 4 + u.pn);
            __hip_atomic_store(slot, ((unsigned long long)__float_as_uint(m2) << 32) | __float_as_uint(mt), __ATOMIC_RELAXED, __HIP_MEMORY_SCOPE_AGENT);
        }
        asm volatile("s_waitcnt vmcnt(0)" ::: "memory");
        if (lane == 0) __hip_atomic_fetch_add(cnt + 64 * u.pm, 1u, __ATOMIC_RELAXED, __HIP_MEMORY_SCOPE_AGENT);
        if (wid == 0) {
            bool dead = false; const unsigned long long t0 = __builtin_amdgcn_s_memrealtime(); const unsigned want = 8u * (unsigned)ntn;
            for (;;) {
#if defined(BROKEN_EXCHANGE_NO_WAIT)
                break;
#endif
                if ((unsigned)__builtin_amdgcn_readfirstlane(__hip_atomic_load(cnt + 64 * u.pm, __ATOMIC_RELAXED, __HIP_MEMORY_SCOPE_AGENT)) >= want) break;
                if (__builtin_amdgcn_s_memrealtime() - t0 > 2000000ull) {
                    if (lane == 0) { unsigned expect = 0u; __hip_atomic_compare_exchange_strong(tmo + 1, &expect, code | (unsigned)(u.pm & 0xff), __ATOMIC_RELAXED, __ATOMIC_RELAXED, __HIP_MEMORY_SCOPE_AGENT);
                                     __hip_atomic_store(tmo, 1u, __ATOMIC_RELAXED, __HIP_MEMORY_SCOPE_AGENT); }
                    dead = true; break; }
                __builtin_amdgcn_s_sleep(2);
            }
            __builtin_amdgcn_fence(__ATOMIC_ACQUIRE, "agent");
            if (lane == 0) flag[0] = dead ? 1u : 0u;
        }
        asm volatile("s_waitcnt vmcnt(0) lgkmcnt(0)" ::: "memory"); __builtin_amdgcn_s_barrier(); asm volatile("" ::: "memory");
        const bool bad = flag[0] != 0u;
        if (lane < 32) {
            const unsigned long long* slot = (const unsigned long long*)xbuf + (size_t)(u.pm * BM + row) * 4; float mt[4], m2[4]; float ms = 0.f;
#pragma unroll
            for (int t = 0; t < 4; ++t) { if (t < ntn) { const unsigned long long w = __hip_atomic_load(slot + t, __ATOMIC_RELAXED, __HIP_MEMORY_SCOPE_AGENT); mt[t] = __uint_as_float((unsigned)w); m2[t] = __uint_as_float((unsigned)(w >> 32)); } else { mt[t] = 0.f; m2[t] = 0.f; } ms += mt[t]; }
            const float mean = ms / (float)ntn; float q = 0.f;
#pragma unroll
            for (int t = 0; t < 4; ++t) if (t < ntn) { const float dm = mt[t] - mean; q += m2[t] + 256.0f * dm * dm; }
            S[row] = (f32x2v){mean, 1.0f / sqrtf(q / (256.0f * (float)ntn) + eps)};
        }
        asm volatile("s_waitcnt lgkmcnt(0)" ::: "memory"); __builtin_amdgcn_s_barrier(); asm volatile("" ::: "memory");
        return bad;
    }
};
struct EpiLnRes {
    static constexpr bool PERM = false, AFTER_DRAIN = true;
    const float* base; float* out; int ldc; const float* bias; PanelStats st; unsigned poison;
    __device__ __forceinline__ void fused(f32x4 (&acc)[2][2][4][2], const Unit& u, int wr, int wc, int fr, int fq, PG8_LAS unsigned char* lds, int wid, int lane) const {
        typedef float f32x2v __attribute__((ext_vector_type(2)));
        const PG8_LAS f32x2v* S = (const PG8_LAS f32x2v*)(lds + 8192);
        const int col0 = u.pn * BM + wc * 32 + 4 * fq;
#pragma unroll
        for (int bj = 0; bj < 2; ++bj)
#pragma unroll
            for (int n = 0; n < 2; ++n) { const f32x4 bv = bias ? *(const f32x4*)(bias + col0 + bj * HALF + n * 16) : (f32x4){0.f, 0.f, 0.f, 0.f};
#pragma unroll
                for (int ai = 0; ai < 2; ++ai)
#pragma unroll
                    for (int m = 0; m < 4; ++m) acc[ai][bj][m][n] += bv; }
        f32x4 pre[4][2][2];
#pragma unroll
        for (int m = 0; m < 4; ++m) { const size_t off = (size_t)(u.pm * BM + wr * 64 + m * 16 + fr) * ldc + col0;
#pragma unroll
            for (int bj = 0; bj < 2; ++bj)
#pragma unroll
                for (int n = 0; n < 2; ++n) pre[m][bj][n] = *(const f32x4*)(base + off + bj * HALF + n * 16); }
        const bool bad = st.run(acc, u, wr, wc, fr, fq, lds, wid, lane) || poison != 0u;
        const float qnan = __builtin_nanf("");
#pragma unroll
        for (int ai = 0; ai < 2; ++ai)
#pragma unroll
            for (int m = 0; m < 4; ++m) { const int r = ai * HALF + wr * 64 + m * 16 + fr; const f32x2v sr = S[r]; const size_t off = (size_t)(u.pm * BM + r) * ldc + col0;
#pragma unroll
                for (int bj = 0; bj < 2; ++bj)
#pragma unroll
                    for (int n = 0; n < 2; ++n) { const f32x4 bs = ai == 0 ? pre[m][bj][n] : *(const f32x4*)(base + off + bj * HALF + n * 16); f32x4 o = bs + (acc[ai][bj][m][n] - sr.x) * sr.y;
                        if (bad) o = (f32x4){qnan, qnan, qnan, qnan}; *(f32x4*)(out + off + bj * HALF + n * 16) = o; }
                if (m & 1) asm volatile("" ::: "memory"); }
    }
};
struct EpiLnResLn {
    static constexpr bool PERM = false, AFTER_DRAIN = true;
    const float* base; float* out; bf16_t* xn; int ldc; const float* bias; PanelStats st1, st2; unsigned poison;
    __device__ __forceinline__ void fused(f32x4 (&acc)[2][2][4][2], const Unit& u, int wr, int wc, int fr, int fq, PG8_LAS unsigned char* lds, int wid, int lane) const {
        typedef float f32x2v __attribute__((ext_vector_type(2))); typedef unsigned u32x2v __attribute__((ext_vector_type(2)));
        const PG8_LAS f32x2v* S = (const PG8_LAS f32x2v*)(lds + 8192);
        const int col0 = u.pn * BM + wc * 32 + 4 * fq;
#pragma unroll
        for (int bj = 0; bj < 2; ++bj)
#pragma unroll
            for (int n = 0; n < 2; ++n) { const f32x4 bv = bias ? *(const f32x4*)(bias + col0 + bj * HALF + n * 16) : (f32x4){0.f, 0.f, 0.f, 0.f};
#pragma unroll
                for (int ai = 0; ai < 2; ++ai)
#pragma unroll
                    for (int m = 0; m < 4; ++m) acc[ai][bj][m][n] += bv; }
        bool bad = st1.run(acc, u, wr, wc, fr, fq, lds, wid, lane) || poison != 0u;
        const float qnan = __builtin_nanf("");
#pragma unroll
        for (int ai = 0; ai < 2; ++ai)
#pragma unroll
            for (int m = 0; m < 4; ++m) { const int r = ai * HALF + wr * 64 + m * 16 + fr; const f32x2v sr = S[r]; const size_t off = (size_t)(u.pm * BM + r) * ldc + col0;
#pragma unroll
                for (int bj = 0; bj < 2; ++bj)
#pragma unroll
                    for (int n = 0; n < 2; ++n) { const f32x4 bs = *(const f32x4*)(base + off + bj * HALF + n * 16); acc[ai][bj][m][n] = bs + (acc[ai][bj][m][n] - sr.x) * sr.y; }
                asm volatile("" : "+v"(acc[ai][0][m][0]), "+v"(acc[ai][0][m][1]), "+v"(acc[ai][1][m][0]), "+v"(acc[ai][1][m][1]));
                if (m & 1) asm volatile("" ::: "memory"); }
        const bool bad1 = bad;
        bad = st2.run(acc, u, wr, wc, fr, fq, lds, wid, lane) || bad;
#pragma unroll
        for (int ai = 0; ai < 2; ++ai)
#pragma unroll
            for (int m = 0; m < 4; ++m) { const int r = ai * HALF + wr * 64 + m * 16 + fr; const f32x2v sr = S[r]; const size_t off = (size_t)(u.pm * BM + r) * ldc + col0;
#pragma unroll
                for (int bj = 0; bj < 2; ++bj)
#pragma unroll
                    for (int n = 0; n < 2; ++n) { const f32x4 x1 = acc[ai][bj][m][n]; *(f32x4*)(out + off + bj * HALF + n * 16) = bad1 ? (f32x4){qnan, qnan, qnan, qnan} : x1;
                        const f32x4 o = (x1 - sr.x) * sr.y; u32x2v w; w.x = cvt_pk_bf16(o[0], o[1]); w.y = cvt_pk_bf16(o[2], o[3]);
                        if (bad) { w.x = 0x7fc07fc0u; w.y = 0x7fc07fc0u; } *(u32x2v*)(xn + off + bj * HALF + n * 16) = w; }
                asm volatile("" ::: "memory"); }
    }
};

template <class Epi, class Sched, bool ALIGN_EPI = false, bool SP2 = false>
__device__ __forceinline__ void gemm_phase(PG8_LAS unsigned char* lds, const Gemm g, const Sched& S, const Epi& E) {
    int tid_ = threadIdx.x; asm volatile("" : "+v"(tid_));
    const int tid = tid_, wid = __builtin_amdgcn_readfirstlane(tid >> 6), lane = tid & 63, wr = wid >> 2, wc = wid & 3, fr = lane & 15, fq = lane >> 4;
    const int K = g.K, nt = K / BK;
    unsigned voffA[2], voffB[2];
#pragma unroll
    for (int i = 0; i < 2; ++i) { int R, C; stage_rc(tid * 16 + i * 8192, R, C); const int Rb = Epi::PERM ? ((R & ~31) + perm32(R & 31)) : R;
        voffA[i] = (unsigned)(R * K + C) * 2u; voffB[i] = (unsigned)(Rb * K + C) * 2u; }
    const size_t kstep = (size_t)(BK * 2);
    const size_t hstep = (size_t)HALF * K * 2;
    const size_t tstep = 2 * hstep;
    const unsigned ldsw = (unsigned)wid * 1024u;
    const int aoff = lds_byte(wr * 64 + fr, fq * 8), boff = lds_byte(wc * 32 + fr, fq * 8);
#define PG8_SA(b, h) (((b) * 2 + (h)) * HTB)
#define PG8_SB(b, h) ((4 + (b) * 2 + (h)) * HTB)
#define PG8_STAGE(bufoff, gbase, voff) do { _Pragma("unroll") for (int _i = 0; _i < 2; ++_i) \
        __builtin_amdgcn_global_load_lds((const unsigned*)((const char*)(gbase) + (voff)[_i]), (PG8_LAS unsigned*)(lds + (bufoff) + ldsw + _i * 8192), 16, 0, 0); } while (0)
#define PG8_LDA(dst, b, h) do { _Pragma("unroll") for (int m = 0; m < 4; ++m) _Pragma("unroll") for (int k = 0; k < 2; ++k) dst[m][k] = *(const PG8_LAS bf16x8*)(lds + PG8_SA(b, h) + aoff + m * 2048 + k * 1024); } while (0)
#define PG8_LDB(dst, b, h) do { _Pragma("unroll") for (int n = 0; n < 2; ++n) _Pragma("unroll") for (int k = 0; k < 2; ++k) dst[n][k] = *(const PG8_LAS bf16x8*)(lds + PG8_SB(b, h) + boff + n * 2048 + k * 1024); } while (0)
#define PG8_MMA(ai, bj, At, Bt) do { __builtin_amdgcn_s_setprio(1); _Pragma("unroll") for (int m = 0; m < 4; ++m) _Pragma("unroll") for (int n = 0; n < 2; ++n) _Pragma("unroll") for (int k = 0; k < 2; ++k) \
        acc[ai][bj][m][n] = __builtin_amdgcn_mfma_f32_16x16x32_bf16(Bt[n][k], At[m][k], acc[ai][bj][m][n], 0, 0, 0); __builtin_amdgcn_s_setprio(0); } while (0)
#define PG8_WAIT_V(n) asm volatile("s_waitcnt vmcnt(" #n ")" ::: "memory")
#define PG8_WAIT_L(n) asm volatile("s_waitcnt lgkmcnt(" #n ")" ::: "memory")
#define PG8_BAR __builtin_amdgcn_s_barrier()
#define PG8_SCHED __builtin_amdgcn_sched_barrier(0)
    Unit cur, nxt; int ui = 0;
    if (!S.next(0, cur)) return;
    f32x4 acc[2][2][4][2];
#pragma unroll
    for (int a = 0; a < 2; ++a)
#pragma unroll
        for (int b = 0; b < 2; ++b)
#pragma unroll
            for (int m = 0; m < 4; ++m)
#pragma unroll
                for (int n = 0; n < 2; ++n) acc[a][b][m][n] = (f32x4){0.f, 0.f, 0.f, 0.f};
    bf16x8 At[4][2], B0[2][2], B1[2][2];
    const char* cA = (const char*)g.A + (size_t)cur.pm * tstep; const char* cB = (const char*)g.Bt + (size_t)cur.pn * tstep;
    S.a_ready(cur);
    if constexpr (SP2) {
        PG8_STAGE(PG8_SB(0, 0), cB, voffB); PG8_STAGE(PG8_SB(0, 1), cB + hstep, voffB); PG8_STAGE(PG8_SA(0, 0), cA, voffA); PG8_STAGE(PG8_SA(0, 1), cA + hstep, voffA);
        if (wr == 1) PG8_BAR;
        PG8_WAIT_V(2); PG8_BAR;
        PG8_STAGE(PG8_SB(1, 0), cB + kstep, voffB); PG8_STAGE(PG8_SA(1, 0), cA + kstep, voffA); PG8_STAGE(PG8_SB(1, 1), cB + hstep + kstep, voffB);
        PG8_WAIT_V(6); PG8_BAR;
    } else {
        PG8_STAGE(PG8_SB(0, 0), cB, voffB); PG8_STAGE(PG8_SA(0, 0), cA, voffA); PG8_STAGE(PG8_SB(0, 1), cB + hstep, voffB); PG8_STAGE(PG8_SA(0, 1), cA + hstep, voffA);
        if (wr == 1) PG8_BAR;
        PG8_WAIT_V(4); PG8_BAR;
        PG8_STAGE(PG8_SB(1, 0), cB + kstep, voffB); PG8_STAGE(PG8_SA(1, 0), cA + kstep, voffA); PG8_STAGE(PG8_SB(1, 1), cB + hstep + kstep, voffB);
        PG8_WAIT_V(6); PG8_BAR;
    }
    for (;;) {
        const bool has_next = S.next(ui + 1, nxt);
        const char* nA = has_next ? (const char*)g.A + (size_t)nxt.pm * tstep : cA; const char* nB = has_next ? (const char*)g.Bt + (size_t)nxt.pn * tstep : cB;
        for (int t = 0; t < nt; t += 2) {
            const bool last = (t == nt - 2);
            const char* a1 = cA + (size_t)(t + 1) * kstep;
            const char* a2 = last ? nA : cA + (size_t)(t + 2) * kstep; const char* b2 = last ? nB : cB + (size_t)(t + 2) * kstep;
            const char* a3 = a2 + kstep; const char* b3 = b2 + kstep;
            if (last && has_next) S.a_ready(nxt);
            if constexpr (SP2) {
            PG8_LDB(B0, 0, 0); PG8_LDB(B1, 0, 1); PG8_SCHED; PG8_LDA(At, 0, 0); PG8_STAGE(PG8_SA(1, 1), a1 + hstep, voffA);
            PG8_WAIT_V(8); PG8_WAIT_L(0); PG8_BAR; PG8_MMA(0, 0, At, B0); PG8_MMA(0, 1, At, B1); PG8_BAR; PG8_SCHED;
            PG8_LDA(At, 0, 1); PG8_STAGE(PG8_SB(0, 0), b2, voffB); PG8_STAGE(PG8_SB(0, 1), b2 + hstep, voffB); PG8_STAGE(PG8_SA(0, 0), a2, voffA);
            PG8_WAIT_V(8); PG8_WAIT_L(0); PG8_BAR; PG8_MMA(1, 0, At, B0); PG8_MMA(1, 1, At, B1); PG8_BAR; PG8_SCHED;
            PG8_LDB(B0, 1, 0); PG8_LDB(B1, 1, 1); PG8_SCHED; PG8_LDA(At, 1, 0); PG8_STAGE(PG8_SA(0, 1), a2 + hstep, voffA);
            PG8_WAIT_V(8); PG8_WAIT_L(0); PG8_BAR; PG8_MMA(0, 0, At, B0); PG8_MMA(0, 1, At, B1); PG8_BAR; PG8_SCHED;
            PG8_LDA(At, 1, 1); PG8_STAGE(PG8_SB(1, 0), b3, voffB); PG8_STAGE(PG8_SB(1, 1), b3 + hstep, voffB); PG8_STAGE(PG8_SA(1, 0), a3, voffA);
            PG8_WAIT_V(8); PG8_WAIT_L(0); PG8_BAR; PG8_MMA(1, 0, At, B0); PG8_MMA(1, 1, At, B1); PG8_BAR; PG8_SCHED;
            } else {
            PG8_LDB(B0, 0, 0); PG8_SCHED; PG8_LDA(At, 0, 0); PG8_STAGE(PG8_SA(1, 1), a1 + hstep, voffA);
            PG8_WAIT_L(8); PG8_BAR; PG8_WAIT_L(0); PG8_MMA(0, 0, At, B0); PG8_BAR; PG8_SCHED;
            PG8_LDB(B1, 0, 1); PG8_STAGE(PG8_SB(0, 0), b2, voffB);
            PG8_BAR; PG8_WAIT_L(0); PG8_MMA(0, 1, At, B1); PG8_BAR;
            PG8_LDA(At, 0, 1); PG8_STAGE(PG8_SA(0, 0), a2, voffA);
            PG8_BAR; PG8_WAIT_L(0); PG8_MMA(1, 0, At, B0); PG8_BAR; PG8_SCHED;
            PG8_STAGE(PG8_SB(0, 1), b2 + hstep, voffB);
            PG8_WAIT_V(6); PG8_BAR; PG8_MMA(1, 1, At, B1); PG8_BAR;
            PG8_LDB(B0, 1, 0); PG8_SCHED; PG8_LDA(At, 1, 0); PG8_STAGE(PG8_SA(0, 1), a2 + hstep, voffA);
            PG8_WAIT_L(8); PG8_BAR; PG8_WAIT_L(0); PG8_MMA(0, 0, At, B0); PG8_BAR; PG8_SCHED;
            PG8_LDB(B1, 1, 1); PG8_STAGE(PG8_SB(1, 0), b3, voffB);
            PG8_BAR; PG8_WAIT_L(0); PG8_MMA(0, 1, At, B1); PG8_BAR;
            PG8_LDA(At, 1, 1); PG8_STAGE(PG8_SA(1, 0), a3, voffA);
            PG8_BAR; PG8_WAIT_L(0); PG8_MMA(1, 0, At, B0); PG8_BAR; PG8_SCHED;
            PG8_STAGE(PG8_SB(1, 1), b3 + hstep, voffB);
            PG8_WAIT_V(6); PG8_BAR; PG8_MMA(1, 1, At, B1); PG8_BAR;
            }
        }
        if constexpr (ALIGN_EPI) { if (wr == 0) PG8_BAR; }
        if constexpr (!Epi::AFTER_DRAIN) { E(acc, cur, wr, wc, fr, fq); S.done(cur); }
        if (!has_next) break;
#pragma unroll
        for (int a = 0; a < 2; ++a)
#pragma unroll
            for (int b = 0; b < 2; ++b)
#pragma unroll
                for (int m = 0; m < 4; ++m)
#pragma unroll
                    for (int n = 0; n < 2; ++n) acc[a][b][m][n] = (f32x4){0.f, 0.f, 0.f, 0.f};
        cur = nxt; cA = nA; cB = nB; ++ui;
        if constexpr (ALIGN_EPI) { if (wr == 1) PG8_BAR; }
    }
    PG8_WAIT_V(0);
    if constexpr (!ALIGN_EPI) { if (wr == 0) PG8_BAR; }
    PG8_BAR;
    if constexpr (Epi::AFTER_DRAIN) { E.fused(acc, cur, wr, wc, fr, fq, lds, wid, lane); S.done(cur); }
#undef PG8_SA
#undef PG8_SB
#undef PG8_STAGE
#undef PG8_LDA
#undef PG8_LDB
#undef PG8_MMA
#undef PG8_WAIT_V
#undef PG8_WAIT_L
#undef PG8_BAR
#undef PG8_SCHED
}
}
#define GAS __attribute__((address_space(1)))
#define LAS __attribute__((address_space(3)))
typedef unsigned short bf16;
typedef unsigned v4u __attribute__((ext_vector_type(4)));
typedef float f32x4 __attribute__((ext_vector_type(4)));
typedef short bf16x8 __attribute__((ext_vector_type(8)));
typedef GAS unsigned gu32;
typedef GAS unsigned long long gu64;
#define RLX_AGENT __ATOMIC_RELAXED, __HIP_MEMORY_SCOPE_AGENT
#define LDS_WAIT() asm volatile("s_waitcnt lgkmcnt(0)" ::: "memory")
#define VM_WAIT() asm volatile("s_waitcnt vmcnt(0)" ::: "memory")
__device__ __forceinline__ unsigned long long rt() { return __builtin_amdgcn_s_memrealtime(); }
__device__ __forceinline__ unsigned f2bf(float f) { unsigned u = __builtin_bit_cast(unsigned, f); return (u + 0x7fffu + ((u >> 16) & 1u)) >> 16; }
__device__ __forceinline__ unsigned pk2(float lo, float hi) { return f2bf(lo) | (f2bf(hi) << 16); }

#define XB_TMO      128
#define XB_XCNT(j)  (256  + 64 * (j))
#define XB_XSUB(j)  (1280 + 64 * (j))
#define XB_XGEN(j)  (2304 + 64 * (j))
#define XB_TOP      3328
#define XB_TOPGEN   3392
#define XCD_BAR_WORDS 3456
#define XB_SPIN_CAP (1u << 18)
#ifndef XB_ACQ_SCOPE
#define XB_ACQ_SCOPE ""
#endif

__device__ __forceinline__ unsigned xb_ld(unsigned* p)              { return __hip_atomic_load(p, __ATOMIC_RELAXED, __HIP_MEMORY_SCOPE_AGENT); }
__device__ __forceinline__ unsigned xb_add(unsigned* p, unsigned v) { return __hip_atomic_fetch_add(p, v, __ATOMIC_RELAXED, __HIP_MEMORY_SCOPE_AGENT); }
__device__ __forceinline__ unsigned xb_xcc_id() { return (unsigned)__builtin_amdgcn_s_getreg((3 << 11) | 20) & 0xFu; }
#define XB_SPIN(cond, bar) do { unsigned _sp = 0; while (cond) { __builtin_amdgcn_s_sleep(1); \
    if ((++_sp & 255u) == 0u) { if (xb_ld(&(bar)[XB_TMO])) break; if (_sp > XB_SPIN_CAP) { atomicAdd(&(bar)[XB_TMO], 1u); break; } } } } while (0)

struct XcdBarrier {
    unsigned* bar; unsigned x;
    volatile LAS unsigned* st;
};

__device__ __forceinline__ XcdBarrier xcd_barrier_post(unsigned* bar, volatile LAS unsigned* st) {
    XcdBarrier b; b.bar = bar; b.x = xb_xcc_id(); b.st = st;
    if (threadIdx.x == 0) (void)xb_add(&bar[XB_XCNT(b.x)], 1u);
    return b;
}
__device__ __forceinline__ void xcd_barrier_complete(unsigned* bar, unsigned x, unsigned& nloc, unsigned& nx) {
    const unsigned G = gridDim.x * gridDim.y * gridDim.z;
    unsigned sum, cnt, mine, sp = 0u;
    for (;;) {
        sum = 0u; cnt = 0u; mine = 0u;
#pragma unroll
        for (unsigned j = 0; j < 16; ++j) { const unsigned c = xb_ld(&bar[XB_XCNT(j)]); sum += c; cnt += (c > 0u) ? 1u : 0u; mine = (j == x) ? c : mine; }
        if (sum == G) break;
        __builtin_amdgcn_s_sleep(1);
        if ((++sp & 255u) == 0u) { if (xb_ld(&bar[XB_TMO])) break; if (sp > XB_SPIN_CAP) { atomicAdd(&bar[XB_TMO], 1u); break; } }
    }
    nloc = mine > 0u ? mine : 1u; nx = cnt > 0u ? cnt : 1u;
}

__device__ __forceinline__ void xcd_barrier(const XcdBarrier& b) {
    asm volatile("s_waitcnt vmcnt(0)" ::: "memory");
    __syncthreads();
    if (threadIdx.x == 0) {
        unsigned* bar = b.bar;
        __builtin_amdgcn_s_waitcnt(0);
        unsigned nloc = b.st[0], nx = b.st[1];
        if (nloc == 0u) { xcd_barrier_complete(bar, b.x, nloc, nx); b.st[0] = nloc; b.st[1] = nx; }
        const unsigned old = xb_add(&bar[XB_XSUB(b.x)], 1u);
        const unsigned gen = old / nloc;
        if (old + 1u == (gen + 1u) * nloc) {
            __builtin_amdgcn_fence(__ATOMIC_RELEASE, "agent");
            asm volatile("s_waitcnt vmcnt(0)" ::: "memory");
            const unsigned og = xb_add(&bar[XB_TOP], 1u);
            const unsigned tg = og / nx;
            if (og + 1u == (tg + 1u) * nx) xb_add(&bar[XB_TOPGEN], 1u);
            else XB_SPIN(xb_ld(&bar[XB_TOPGEN]) == tg, bar);
            __builtin_amdgcn_fence(__ATOMIC_ACQUIRE, XB_ACQ_SCOPE);
            xb_add(&bar[XB_XGEN(b.x)], 1u);
            asm volatile("s_waitcnt vmcnt(0)" ::: "memory");
        } else {
            XB_SPIN(xb_ld(&bar[XB_XGEN(b.x)]) == gen, bar);
            __builtin_amdgcn_fence(__ATOMIC_ACQUIRE, XB_ACQ_SCOPE);
            asm volatile("s_waitcnt vmcnt(0)" ::: "memory");
        }
    }
    __syncthreads();
}

constexpr int NB = 2, T = 8192, DM = 1024, M = NB * T, NMETA = 16, LK = T + NMETA;
constexpr int DFF = 2816, PW = 11264;
constexpr float NORM_EPS = 1e-6f, GN_EPS = 1e-5f;
constexpr int NWAVES = 8;
constexpr float LOG2E = 1.4426950408889634f;
constexpr float ROPE_C = 13.287712379549449f / 128.0f;
constexpr float INV_2PI = 0.15915494309189535f;

typedef float f32x16 __attribute__((ext_vector_type(16)));
typedef short s16x4 __attribute__((ext_vector_type(4)));
typedef short v4i16_t __attribute__((ext_vector_type(4)));
typedef float f32x2v __attribute__((ext_vector_type(2)));
typedef unsigned u32x2v __attribute__((ext_vector_type(2)));

constexpr size_t MiB = 1u << 20;
constexpr size_t WS_CTL = 0, CTL_ZERO_BYTES = 1 * MiB;
constexpr size_t WS_WIN = 1 * MiB, WS_WRO = 23 * MiB, WS_WSO = 27 * MiB, WS_WOUT = 29 * MiB, WS_WFI = 31 * MiB, WS_WFO = 42 * MiB;
constexpr size_t WS_MP = 47 * MiB + 512 * 1024;
constexpr size_t WS_GS = 48 * MiB;
constexpr size_t WS_XN = 49 * MiB;
constexpr size_t WS_R = 81 * MiB;
constexpr size_t WS_RQ = WS_R;
constexpr size_t WS_RK = WS_R + 32 * MiB;
constexpr size_t WS_PB = WS_R + 64 * MiB;
constexpr size_t WS_MKV = 47 * MiB + 512 * 1024 + 384 * 1024;
constexpr size_t WS_YR = 192 * MiB;
constexpr size_t WS_GA = WS_RK, WS_GB = WS_R + 64 * MiB;
constexpr size_t WS_MG = WS_XN;
constexpr size_t WS_HN2 = WS_RK;
constexpr size_t WS_ACT = WS_R + 64 * MiB;
constexpr size_t WS_FF = WS_R;
constexpr size_t WS_END = 256 * MiB;
static_assert(WS_MKV + 65536 <= WS_GS, "ws map");
static_assert(WS_ACT + (size_t)M * DFF * 2 <= WS_END && WS_WFO + (size_t)DM * DFF * 2 <= WS_MP, "ws map");
constexpr int CW_BAR = 4096, CW_TICKET = 1024  , CW_BAD = 2000;

constexpr int RING_BYTES = 131072;
constexpr int LDSCTL_OFF = RING_BYTES, MISC_OFF = LDSCTL_OFF + 320;
constexpr int LDS_BYTES = 147456;

typedef pg8::Unit Unit;

typedef __bf16 bf16x2_t __attribute__((ext_vector_type(2)));
__device__ __forceinline__ unsigned cvtpk_s(float lo, float hi) { f32x2v v = {lo, hi}; bf16x2_t b = __builtin_convertvector(v, bf16x2_t); return __builtin_bit_cast(unsigned, b); }
__device__ __forceinline__ float fsigmoid(float x) { return __builtin_amdgcn_rcpf(1.f + __builtin_amdgcn_exp2f(-LOG2E * x)); }
template <class Tp> __device__ __forceinline__ const Tp* uniform_ptr(const Tp* p) { const unsigned long long a = (unsigned long long)p; const unsigned lo = __builtin_amdgcn_readfirstlane((unsigned)a), hi = __builtin_amdgcn_readfirstlane((unsigned)(a >> 32)); return (const Tp*)(((unsigned long long)hi << 32) | lo); }
__device__ __forceinline__ int opaque(int v) { asm volatile("" : "+v"(v)); return v; }
__device__ __forceinline__ int crow(int reg, int h) { return (reg & 3) + 8 * (reg >> 2) + 4 * h; }
__device__ __forceinline__ v4u pack8(const f32x4& a, const f32x4& b) { v4u w; w.x = cvtpk_s(a[0], a[1]); w.y = cvtpk_s(a[2], a[3]); w.z = cvtpk_s(b[0], b[1]); w.w = cvtpk_s(b[2], b[3]); return w; }
__device__ __forceinline__ float bf2f(unsigned short b) { return __uint_as_float(((unsigned)b) << 16); }
__device__ __forceinline__ void unpack8(const v4u& w, float (&o)[8]) {
    o[0] = __uint_as_float(w.x << 16); o[1] = __uint_as_float(w.x & 0xffff0000u); o[2] = __uint_as_float(w.y << 16); o[3] = __uint_as_float(w.y & 0xffff0000u);
    o[4] = __uint_as_float(w.z << 16); o[5] = __uint_as_float(w.z & 0xffff0000u); o[6] = __uint_as_float(w.w << 16); o[7] = __uint_as_float(w.w & 0xffff0000u); }
__device__ __forceinline__ s16x4 tr_read(const LAS unsigned char* p) { return __builtin_bit_cast(s16x4, __builtin_amdgcn_ds_read_tr16_b64_v4i16((LAS v4i16_t*)p)); }
__device__ __forceinline__ bf16x8 cat8(s16x4 lo, s16x4 hi) { return (bf16x8){lo[0], lo[1], lo[2], lo[3], hi[0], hi[1], hi[2], hi[3]}; }
#define MFMA32(a, b, c) __builtin_amdgcn_mfma_f32_32x32x16_bf16((a), (b), (c), 0, 0, 0)

struct EpiP1 {
    static constexpr bool PERM = true, AFTER_DRAIN = false;
    bf16* RQ; bf16* RK; bf16* RV;
    __device__ __forceinline__ void operator()(const f32x4 (&acc)[2][2][4][2], const Unit& u, int wr, int wc, int fr, int fq) const {
        int pm_ = u.pm, pn_ = u.pn; asm volatile("" : "+s"(pm_), "+s"(pn_)); const int row0 = pm_ * 256 + wr * 64 + fr; const int pn = pn_;
        if (pn >= 8) {
            const int col0 = (pn - 8) * 256 + wc * 32 + 8 * fq;
            const __amdgpu_buffer_rsrc_t rsrc = __builtin_amdgcn_make_buffer_rsrc((void*)RV, 0, M * 2048 * 2, 0x00020000);
#pragma unroll
            for (int ai = 0; ai < 2; ++ai)
#pragma unroll
                for (int m = 0; m < 4; ++m) { const int boff = ((row0 + ai * 128 + m * 16) * 2048 + col0) * 2;
#pragma unroll
                    for (int bj = 0; bj < 2; ++bj) __builtin_amdgcn_raw_buffer_store_b128(pack8(acc[ai][bj][m][0], acc[ai][bj][m][1]), rsrc, boff + bj * 256, 0, 16); }
        } else {
            const bool isq = pn < 4; const int h = pn & 3;
            bf16* base = (isq ? RQ : RK);
            const int blk0 = 2 * wc + (fq >> 1), lsel = 32 * (fq & 1);
            float cj[2][4];
#pragma unroll
            for (int n = 0; n < 2; ++n)
#pragma unroll
                for (int i = 0; i < 4; ++i) cj[n][i] = __builtin_amdgcn_exp2f(-(float)(wc * 32 + 8 * fq + 4 * n + i) * ROPE_C) * INV_2PI;
            const float lg2 = log2f(1.f - exp2f(-(float)(5 + h)));
#pragma unroll
            for (int ai = 0; ai < 2; ++ai)
#pragma unroll
                for (int m = 0; m < 4; ++m) {
                    const int r = row0 + ai * 128 + m * 16; const int t = r & (T - 1); const float pos = (float)(t + NMETA); const float c = (float)(t & 127);
                    const float rs = isq ? 0.0625f * __builtin_amdgcn_exp2f(lg2 * c) : __builtin_amdgcn_exp2f(-lg2 * c);
                    f32x4 o1[2], o2[2]; f32x4 xa[2] = {acc[ai][0][m][0], acc[ai][0][m][1]}, xb[2] = {acc[ai][1][m][0], acc[ai][1][m][1]};
                    asm volatile("" : "+v"(xa[0]), "+v"(xa[1]), "+v"(xb[0]), "+v"(xb[1]));
#pragma unroll
                    for (int n = 0; n < 2; ++n)
#pragma unroll
                        for (int i = 0; i < 4; ++i) {
                            const float x1 = xa[n][i], x2 = xb[n][i];
                            const float rev = __builtin_amdgcn_fractf(pos * cj[n][i]);
                            const float sn = __builtin_amdgcn_sinf(rev), cs = __builtin_amdgcn_cosf(rev);
                            o1[n][i] = (x1 * cs - x2 * sn) * rs; o2[n][i] = (x1 * sn + x2 * cs) * rs; }
                    bf16* rowp = base + ((size_t)((r >> 5) * 4 + h) * 16 + blk0) * 512 + ((r & 31) + lsel) * 8;
                    *(v4u*)(rowp) = pack8(o1[0], o1[1]); *(v4u*)(rowp + 8 * 512) = pack8(o2[0], o2[1]); asm volatile("" ::: "memory"); }
        }
    }
};
struct EpiP3 {
    static constexpr bool PERM = true, AFTER_DRAIN = false;
    bf16* SQ; bf16* SK; bf16* SV;
    __device__ __forceinline__ void operator()(const f32x4 (&acc)[2][2][4][2], const Unit& u, int wr, int wc, int fr, int fq) const {
        int pm_ = u.pm, pn_ = u.pn; asm volatile("" : "+s"(pm_), "+s"(pn_)); const int row0 = pm_ * 256 + wr * 64 + fr; const int pn = pn_; const int sel = pn >> 2;
        const int col0 = (pn & 3) * 256 + wc * 32 + 8 * fq;
        bf16* base = SQ + (sel >= 1 ? (SK - SQ) : 0) + (sel >= 2 ? (SV - SK) : 0);
        const float sc = sel == 0 ? 0.125f * LOG2E : 1.f;
#pragma unroll
        for (int ai = 0; ai < 2; ++ai)
#pragma unroll
            for (int m = 0; m < 4; ++m) { const int r = row0 + ai * 128 + m * 16;
                bf16* rowp = base + (size_t)r * DM + col0;
#pragma unroll
                for (int bj = 0; bj < 2; ++bj) *(v4u*)(rowp + bj * 128) = pack8(acc[ai][bj][m][0] * sc, acc[ai][bj][m][1] * sc);
                asm volatile("" ::: "memory"); }
    }
};
struct EpiRG {
    static constexpr bool PERM = true, AFTER_DRAIN = false;
    bf16* YR; const f32x2v* GS;
    __device__ __forceinline__ void operator()(const f32x4 (&acc)[2][2][4][2], const Unit& u, int wr, int wc, int fr, int fq) const {
        int pm_ = u.pm, pn_ = u.pn; asm volatile("" : "+s"(pm_), "+s"(pn_)); const int row0 = pm_ * 256 + wr * 64 + fr; const int pn = pn_;
        const int h = pn >> 1; const int col0 = pn * 256 + wc * 32 + 8 * fq;
#pragma unroll
        for (int ai = 0; ai < 2; ++ai)
#pragma unroll
            for (int m = 0; m < 4; ++m) { const int r = row0 + ai * 128 + m * 16; const f32x2v st = GS[(size_t)r * 4 + h];
                bf16* rowp = YR + (size_t)r * 2048 + col0;
#pragma unroll
                for (int bj = 0; bj < 2; ++bj) { const v4u yv = *(const v4u*)(rowp + bj * 128); float y[8]; unpack8(yv, y);
                    f32x4 o0, o1;
                    f32x4 xa = acc[ai][bj][m][0], xb = acc[ai][bj][m][1]; asm volatile("" : "+v"(xa), "+v"(xb));
#pragma unroll
                    for (int i = 0; i < 4; ++i) { const float a = xa[i], b = xb[i];
                        o0[i] = a * fsigmoid(a) * ((y[i] - st.x) * st.y); o1[i] = b * fsigmoid(b) * ((y[4 + i] - st.x) * st.y); }
                    *(v4u*)(rowp + bj * 128) = pack8(o0, o1); }
                asm volatile("" ::: "memory"); }
    }
};
struct EpiSig {
    static constexpr bool PERM = true, AFTER_DRAIN = false;
    bf16* GA; bf16* GB;
    __device__ __forceinline__ void operator()(const f32x4 (&acc)[2][2][4][2], const Unit& u, int wr, int wc, int fr, int fq) const {
        int pm_ = u.pm, pn_ = u.pn; asm volatile("" : "+s"(pm_), "+s"(pn_)); const int row0 = pm_ * 256 + wr * 64 + fr; const int pn = pn_;
        bf16* base = GA + (pn >= 4 ? (GB - GA) : 0); const int col0 = (pn & 3) * 256 + wc * 32 + 8 * fq;
#pragma unroll
        for (int ai = 0; ai < 2; ++ai)
#pragma unroll
            for (int m = 0; m < 4; ++m) { bf16* rowp = base + (size_t)(row0 + ai * 128 + m * 16) * DM + col0;
#pragma unroll
                for (int bj = 0; bj < 2; ++bj) { f32x4 o0, o1;
                    f32x4 xa = acc[ai][bj][m][0], xb = acc[ai][bj][m][1]; asm volatile("" : "+v"(xa), "+v"(xb));
#pragma unroll
#if defined(DEBUG_SIGID)
                    for (int i = 0; i < 4; ++i) { o0[i] = xa[i]; o1[i] = xb[i]; }
#else
                    for (int i = 0; i < 4; ++i) { o0[i] = fsigmoid(xa[i]); o1[i] = fsigmoid(xb[i]); }
#endif
                    *(v4u*)(rowp + bj * 128) = pack8(o0, o1); }
                asm volatile("" ::: "memory"); }
    }
};
template <bool SECOND> struct EpiP6 {
    static constexpr bool PERM = true, AFTER_DRAIN = false;
    bf16* MG; const bf16* GT;
    __device__ __forceinline__ void operator()(const f32x4 (&acc)[2][2][4][2], const Unit& u, int wr, int wc, int fr, int fq) const {
        int pm_ = u.pm, pn_ = u.pn; asm volatile("" : "+s"(pm_), "+s"(pn_)); const int row0 = pm_ * 256 + wr * 64 + fr; const int col0 = pn_ * 256 + wc * 32 + 8 * fq;
#pragma unroll
        for (int ai = 0; ai < 2; ++ai)
#pragma unroll
            for (int m = 0; m < 4; ++m) { const size_t off = (size_t)(row0 + ai * 128 + m * 16) * DM + col0;
#pragma unroll
                for (int bj = 0; bj < 2; ++bj) { const v4u gv = *(const v4u*)(GT + off + bj * 128); float g[8]; unpack8(gv, g); float p[8];
                    if (SECOND) { const v4u pv = *(const v4u*)(MG + off + bj * 128); unpack8(pv, p); }
                    f32x4 o0, o1;
#pragma unroll
                    for (int i = 0; i < 4; ++i) { o0[i] = acc[ai][bj][m][0][i] * g[i]; o1[i] = acc[ai][bj][m][1][i] * g[4 + i]; if (SECOND) { o0[i] += p[i]; o1[i] += p[4 + i]; } }
                    *(v4u*)(MG + off + bj * 128) = pack8(o0, o1); }
                asm volatile("" ::: "memory"); }
    }
};
struct EpiF32 {
    static constexpr bool PERM = false, AFTER_DRAIN = false;
    float* C; int ldc;
    __device__ __forceinline__ void operator()(const f32x4 (&acc)[2][2][4][2], const Unit& u, int wr, int wc, int fr, int fq) const {
        int pm_ = u.pm, pn_ = u.pn; asm volatile("" : "+s"(pm_), "+s"(pn_)); const int row0 = pm_ * 256 + wr * 64 + fr, col0 = pn_ * 256 + wc * 32 + 4 * fq;
#pragma unroll
        for (int ai = 0; ai < 2; ++ai)
#pragma unroll
            for (int m = 0; m < 4; ++m) { float* rowp = C + (size_t)(row0 + ai * 128 + m * 16) * ldc + col0;
#pragma unroll
                for (int bj = 0; bj < 2; ++bj)
#pragma unroll
                    for (int n = 0; n < 2; ++n) *(f32x4*)(rowp + bj * 128 + n * 16) = acc[ai][bj][m][n]; }
    }
};
struct EpiP8 {
    static constexpr bool PERM = true, AFTER_DRAIN = false;
    bf16* ACT;
    __device__ __forceinline__ void operator()(const f32x4 (&acc)[2][2][4][2], const Unit& u, int wr, int wc, int fr, int fq) const {
        int pm_ = u.pm, pn_ = u.pn; asm volatile("" : "+s"(pm_), "+s"(pn_)); const int row0 = pm_ * 256 + wr * 64 + fr; const int col0 = pn_ * 128 + wc * 32 + 8 * fq;
#pragma unroll
        for (int ai = 0; ai < 2; ++ai)
#pragma unroll
            for (int m = 0; m < 4; ++m) { bf16* rowp = ACT + (size_t)(row0 + ai * 128 + m * 16) * DFF + col0; f32x4 o0, o1;
                f32x4 xa = acc[ai][0][m][0], xb = acc[ai][0][m][1]; asm volatile("" : "+v"(xa), "+v"(xb));
#pragma unroll
                for (int i = 0; i < 4; ++i) { const float a0 = xa[i], a1 = xb[i];
                    o0[i] = a0 * fsigmoid(a0) * acc[ai][1][m][0][i]; o1[i] = a1 * fsigmoid(a1) * acc[ai][1][m][1][i]; }
                *(v4u*)rowp = pack8(o0, o1); asm volatile("" ::: "memory"); }
    }
};

struct Frame {
    LAS unsigned char* lds;
    volatile LAS unsigned* MISC;
    gu32* ctl;
    int tid, lane, wave;
    int vcu, G;
    int xcc, tk, cg;
    const float *x, *meta, *w_in, *w_ro, *w_so, *w_out, *w_fi, *w_fo, *g_pre, *g_post, *g_fpre, *g_fpost; float* out;
    unsigned char* ws;
};
__device__ __forceinline__ float wave_sum(float v) {
#pragma unroll
    for (int o = 1; o < 64; o <<= 1) v += __shfl_xor(v, o);
    return v;
}
__device__ __forceinline__ void p0_transpose_item(const float* W, int K, int N, bf16* WT, int dst_row0, LAS float* scr, int kb, int nb, int lane) {
    const int k0 = 64 * kb, n0 = 32 * nb;
#pragma unroll 8
    for (int i = 0; i < 32; ++i) { const int kk = 2 * i + (lane >> 5); scr[kk * 33 + (lane & 31)] = W[(size_t)(k0 + kk) * N + n0 + (lane & 31)]; }
    LDS_WAIT(); asm volatile("" ::: "memory");
    const int c = lane & 7;
#pragma unroll
    for (int j = 0; j < 4; ++j) { const int n = (lane >> 3) + 8 * j; const LAS float* s = scr + (8 * c) * 33 + n;
        v4u o; o.x = pk2(s[0 * 33], s[1 * 33]); o.y = pk2(s[2 * 33], s[3 * 33]); o.z = pk2(s[4 * 33], s[5 * 33]); o.w = pk2(s[6 * 33], s[7 * 33]);
        *(GAS v4u*)(WT + (size_t)(dst_row0 + n) * K + k0 + 8 * c) = o; }
    LDS_WAIT(); asm volatile("" ::: "memory");
}
__device__ __forceinline__ int map_in(int n) { return n < 4096 ? n : (n < 6144 ? n + 3072 : (n < 9216 ? n - 2048 : n)); }
__device__ __forceinline__ int map_fi(int n) { return n < DFF ? (n >> 7) * 256 + (n & 127) : ((n - DFF) >> 7) * 256 + 128 + ((n - DFF) & 127); }
__device__ __forceinline__ void rms_row_to_bf16(const float* xrow, const float* gain, bf16* orow, int lane) {
    const GAS f32x4* xr = (const GAS f32x4*)xrow + lane; const GAS f32x4* gr = (const GAS f32x4*)gain + lane;
    f32x4 v[4]; float s = 0.f;
#pragma unroll
    for (int j = 0; j < 4; ++j) { v[j] = xr[64 * j]; s += (v[j].x * v[j].x + v[j].y * v[j].y) + (v[j].z * v[j].z + v[j].w * v[j].w); }
    const float rs = 1.f / sqrtf(wave_sum(s) * (1.f / DM) + NORM_EPS);
    GAS unsigned long long* o8 = (GAS unsigned long long*)orow + lane;
#pragma unroll
    for (int j = 0; j < 4; ++j) { const f32x4 g = gr[64 * j]; o8[64 * j] = (unsigned long long)pk2(v[j].x * rs * g.x, v[j].y * rs * g.y) | ((unsigned long long)pk2(v[j].z * rs * g.z, v[j].w * rs * g.w) << 32); }
}

__device__ __forceinline__ void p0_prologue(Frame& F0) {
    Frame F = F0; F.tid = opaque((int)threadIdx.x); F.lane = F.tid & 63; F.wave = __builtin_amdgcn_readfirstlane(F.tid >> 6);
    bf16* WIN = (bf16*)(F.ws + WS_WIN); bf16* WRO = (bf16*)(F.ws + WS_WRO); bf16* WSO = (bf16*)(F.ws + WS_WSO); bf16* WOUT = (bf16*)(F.ws + WS_WOUT);
    bf16* WFI = (bf16*)(F.ws + WS_WFI); bf16* WFO = (bf16*)(F.ws + WS_WFO); bf16* XN = (bf16*)(F.ws + WS_XN); float* MP = (float*)(F.ws + WS_MP);
    if (F.vcu < 80) {
        LAS float* hnT = (LAS float*)F.lds;
        LAS float* red = hnT + 16 * 1024;
#pragma unroll
        for (int rr = 0; rr < 2; ++rr) { const int row = 2 * F.wave + rr; const float* mr = F.meta + (size_t)row * DM;
            float v[16]; float s = 0.f;
#pragma unroll
            for (int j = 0; j < 16; ++j) { v[j] = mr[F.lane + 64 * j]; s += v[j] * v[j]; }
            const float rs = 1.f / sqrtf(wave_sum(s) * (1.f / DM) + NORM_EPS);
#pragma unroll
            for (int j = 0; j < 16; ++j) hnT[(F.lane + 64 * j) * 16 + row] = v[j] * rs * F.g_pre[F.lane + 64 * j]; }
        __syncthreads();
        const int mpcol = 64 * F.vcu + F.lane; const int orig = mpcol < 3072 ? mpcol + 1024 : mpcol + 4096;
        float acc[16];
#pragma unroll
        for (int i = 0; i < 16; ++i) acc[i] = 0.f;
        const float* wp = F.w_in + (size_t)(128 * F.wave) * PW + orig;
#pragma unroll 8
        for (int k = 0; k < 128; ++k) { const float wv = wp[(size_t)k * PW]; const LAS f32x4* hv = (const LAS f32x4*)(hnT + (128 * F.wave + k) * 16);
#pragma unroll
            for (int q = 0; q < 4; ++q) { const f32x4 hq = hv[q]; acc[4 * q] += hq.x * wv; acc[4 * q + 1] += hq.y * wv; acc[4 * q + 2] += hq.z * wv; acc[4 * q + 3] += hq.w * wv; } }
#pragma unroll
        for (int i = 0; i < 16; ++i) red[(F.wave * 16 + i) * 64 + F.lane] = acc[i];
        __syncthreads();
        for (int o = F.tid; o < 1024; o += 512) { const int i = o >> 6, c = o & 63; float s = 0.f;
#pragma unroll
            for (int w = 0; w < 8; ++w) s += red[(w * 16 + i) * 64 + c];
            MP[i * 5120 + 64 * F.vcu + c] = s;
            const int mc = 64 * F.vcu + c; bf16* MKV = (bf16*)(F.ws + WS_MKV);
            if (mc >= 3072) MKV[(mc >= 4096 ? 16 * DM + (mc - 4096) : (mc - 3072)) + i * DM] = (bf16)f2bf(s); }
        __syncthreads();
    }
    LAS float* scr = (LAS float*)(F.lds + F.wave * 16384);
    const int gw = F.vcu * NWAVES + F.wave, NGW = F.G * NWAVES;
    constexpr int I_IN = 16 * (PW / 32), I_RO = 32 * 32, I_SO = 16 * 32, I_OUT = 16 * 32, I_FI = 16 * (2 * DFF / 32), I_FO = (DFF / 64) * 32;
    constexpr int NITEMS = I_IN + I_RO + I_SO + I_OUT + I_FI + I_FO;
    for (int it = gw; it < NITEMS; it += NGW) {
        int r = it;
        if (r < I_IN) { const int nbk = PW / 32, kb = r / nbk, nb = r % nbk; p0_transpose_item(F.w_in, DM, PW, WIN, map_in(32 * nb), scr, kb, nb, F.lane); continue; } r -= I_IN;
        if (r < I_RO) { const int kb = r / 32, nb = r % 32; p0_transpose_item(F.w_ro, 2048, DM, WRO, 32 * nb, scr, kb, nb, F.lane); continue; } r -= I_RO;
        if (r < I_SO) { const int kb = r / 32, nb = r % 32; p0_transpose_item(F.w_so, DM, DM, WSO, 32 * nb, scr, kb, nb, F.lane); continue; } r -= I_SO;
        if (r < I_OUT) { const int kb = r / 32, nb = r % 32; p0_transpose_item(F.w_out, DM, DM, WOUT, 32 * nb, scr, kb, nb, F.lane); continue; } r -= I_OUT;
        if (r < I_FI) { const int nbk = 2 * DFF / 32, kb = r / nbk, nb = r % nbk; p0_transpose_item(F.w_fi, DM, 2 * DFF, WFI, map_fi(32 * nb), scr, kb, nb, F.lane); continue; } r -= I_FI;
        { const int kb = r / 32, nb = r % 32; p0_transpose_item(F.w_fo, DFF, DM, WFO, 32 * nb, scr, kb, nb, F.lane); }
    }
    for (int k = 0; k < 8; ++k) { const int m = 2048 * F.xcc + F.tk * 8 + F.wave + 256 * k; rms_row_to_bf16(F.x + (size_t)m * DM, F.g_pre, XN + (size_t)m * DM, F.lane); }
}

__device__ __forceinline__ void scores_phase(Frame& F0) {
    Frame F = F0; F.tid = opaque((int)threadIdx.x); F.lane = F.tid & 63; F.wave = __builtin_amdgcn_readfirstlane(F.tid >> 6);
    const bf16* RQ = (const bf16*)(F.ws + WS_RQ); const bf16* RK = (const bf16*)(F.ws + WS_RK); bf16* PB = (bf16*)(F.ws + WS_PB);
    const int w = F.wave, lane = F.lane, r = lane & 31, hh = lane >> 5;
    for (int li = 0; li < 2; ++li) { const int lu = F.tk + 32 * li;
        const int h = lu & 3, b = F.xcc >> 2, nn = 16 * (F.xcc & 3) + (lu >> 2), bh = b * 4 + h, uid = bh * 64 + nn; const int rb0 = (b * T + 128 * nn) >> 5;
        const int cb = w >> 1, sh = w & 1;
        const bf16* qp = RQ + ((size_t)((rb0 + cb) * 4 + h) * 16) * 512 + lane * 8;
        bf16x8 bq[16];
#pragma unroll
        for (int ks = 0; ks < 16; ++ks) bq[ks] = *(const bf16x8*)(qp + ks * 512);
#pragma unroll
        for (int jj = 0; jj < 2; ++jj) { const int sb = 2 * sh + jj; f32x16 acc;
#pragma unroll
            for (int i = 0; i < 16; ++i) acc[i] = 0.f;
            if (sb <= cb) { const bf16* kp = RK + ((size_t)((rb0 + sb) * 4 + h) * 16) * 512 + lane * 8;
#pragma unroll
                for (int ks = 0; ks < 16; ++ks) { const bf16x8 ak = *(const bf16x8*)(kp + ks * 512); acc = MFMA32(ak, bq[ks], acc); } }
            float v[16];
#pragma unroll
            for (int i = 0; i < 16; ++i) v[i] = (32 * sb + crow(i, hh) <= 32 * cb + r) ? acc[i] : 0.f;
            bf16* pout = PB + (size_t)uid * 16384 + ((cb * 4 + sb) * 64 + lane) * 16;
            v4u w0, w1; w0.x = cvtpk_s(v[0], v[1]); w0.y = cvtpk_s(v[2], v[3]); w0.z = cvtpk_s(v[4], v[5]); w0.w = cvtpk_s(v[6], v[7]);
            w1.x = cvtpk_s(v[8], v[9]); w1.y = cvtpk_s(v[10], v[11]); w1.z = cvtpk_s(v[12], v[13]); w1.w = cvtpk_s(v[14], v[15]);
            *(v4u*)pout = w0; *(v4u*)(pout + 8) = w1;
        }
    }
}

__device__ __forceinline__ void scan_phase(Frame& F0) {
    Frame F = F0; F.tid = opaque((int)threadIdx.x); F.lane = F.tid & 63; F.wave = __builtin_amdgcn_readfirstlane(F.tid >> 6);
    if (F.tk >= 16) return;
    const int bh = F.xcc, b = bh >> 2, h = bh & 3, es = F.tk;
    const int w = F.wave, lane = F.lane, r = lane & 31, hh = lane >> 5, tid = F.tid;
    const int i16 = lane & 15, q4 = i16 >> 2, p4 = i16 & 3, blk = (lane >> 4) & 1;
    constexpr int KP = 528, VP = 80;
    LAS unsigned char* KT = F.lds;
    LAS unsigned char* VL = KT + 128 * KP;
    LAS unsigned char* ST = VL + 128 * VP;
    LAS unsigned char* YT = ST + 32 * KP;
    const bf16* RQ = (const bf16*)(F.ws + WS_RQ); const bf16* RK = (const bf16*)(F.ws + WS_RK); const bf16* PB = (const bf16*)(F.ws + WS_PB);
    bf16* YR = (bf16*)(F.ws + WS_YR); const float* MP = (const float*)(F.ws + WS_MP);
    const float g = 1.f - exp2f(-(float)(5 + h)); const float lg2 = log2f(g);
    const float gamma = exp2f(lg2 * 128.f), c127 = exp2f(lg2 * 127.f);
    f32x16 st;
    {
        LAS float* km = (LAS float*)F.lds; LAS float* vm = km + 16 * 256;
        for (int idx = tid; idx < 16 * 128; idx += 512) { const int i = idx >> 7, d = idx & 127;
            const float x1 = MP[i * 5120 + h * 256 + d], x2 = MP[i * 5120 + h * 256 + d + 128];
            const float rev = __builtin_amdgcn_fractf((float)i * __builtin_amdgcn_exp2f(-(float)d * ROPE_C) * INV_2PI);
            const float sn = __builtin_amdgcn_sinf(rev), cs = __builtin_amdgcn_cosf(rev), sc = exp2f(lg2 * (float)(15 - i));
            km[i * 256 + d] = (x1 * cs - x2 * sn) * sc; km[i * 256 + d + 128] = (x1 * sn + x2 * cs) * sc; }
        for (int idx = tid; idx < 16 * 32; idx += 512) { const int i = idx >> 5, e = idx & 31; vm[i * 32 + e] = MP[i * 5120 + 1024 + h * 512 + 32 * es + e]; }
        __syncthreads();
#pragma unroll
        for (int reg = 0; reg < 16; ++reg) st[reg] = 0.f;
#pragma unroll 1
        for (int i = 0; i < 16; ++i) { const float vv = vm[i * 32 + r];
#pragma unroll
            for (int reg = 0; reg < 16; ++reg) st[reg] += km[i * 256 + 32 * w + crow(reg, hh)] * vv; }
        __syncthreads();
        const float ic = 1.f / c127;
#pragma unroll
        for (int reg = 0; reg < 16; ++reg) st[reg] *= ic;
    }
    const float gc = g * c127;
    const int t4 = tid & 255; const unsigned yoff = (unsigned)((tid >> 2) * 2048 + (tid & 3) * 8); const unsigned voff = (unsigned)((t4 >> 2) * 2048 + (t4 & 3) * 8);
    v4u pre[18];
#define SCAN_LOAD_KV(nn_) do { const int rb0_ = (b * T + 128 * (nn_)) >> 5; \
        _Pragma("unroll") for (int i = 0; i < 16; ++i) { const bf16* kb_ = uniform_ptr(RK + ((size_t)((rb0_ + (i >> 2)) * 4 + h) * 16) * 512 + (i & 3) * 2048);     \
            pre[i] = *(const v4u*)(kb_ + t4 * 8); } \
        _Pragma("unroll") for (int i = 0; i < 2; ++i) { const bf16* vb_ = uniform_ptr(YR + (size_t)(b * T + 128 * (nn_) + 64 * i) * 2048 + h * 512 + 32 * es); pre[16 + i] = *(const v4u*)(vb_ + voff); } } while (0)
#define SCAN_LOAD_QP(nn_) do { const int rb0_ = (b * T + 128 * (nn_)) >> 5; const bf16* qp_ = RQ + ((size_t)((rb0_ + w) * 4 + h) * 16) * 512;     \
        _Pragma("unroll") for (int ks = 0; ks < 16; ++ks) pre[ks] = *(const v4u*)(uniform_ptr(qp_ + ks * 512) + lane * 8); } while (0)
    if (w >= 4) SCAN_LOAD_KV(0); else SCAN_LOAD_QP(0);
    for (int nn = 0; nn < 64; ++nn) {
        const int m0 = b * T + 128 * nn;
        if (nn > 0) { const v4u yv = *(const LAS v4u*)(YT + (tid >> 2) * VP + (tid & 3) * 16);
            bf16* yb = YR + (size_t)(m0 - 128) * 2048 + h * 512 + 32 * es; *(v4u*)(yb + yoff) = yv; }
        if (w >= 4) {
#pragma unroll
            for (int i = 0; i < 16; ++i) *(LAS v4u*)(KT + (t4 & 31) * KP + (16 * (t4 >> 6) + 8 * ((t4 >> 5) & 1)) * 2 + (i >> 2) * 32 * KP + (i & 3) * 128) = pre[i];
#pragma unroll
            for (int i = 0; i < 2; ++i) *(LAS v4u*)(VL + (t4 >> 2) * VP + (t4 & 3) * 16 + i * 64 * VP) = pre[16 + i];
        }
#pragma unroll
        for (int gq = 0; gq < 4; ++gq) { u32x2v pv; pv.x = cvtpk_s(st[4 * gq], st[4 * gq + 1]); pv.y = cvtpk_s(st[4 * gq + 2], st[4 * gq + 3]);
            *(LAS u32x2v*)(ST + r * KP + (32 * w + 8 * gq + 4 * hh) * 2) = pv; }
        __syncthreads();
        if (w >= 4) { if (nn + 1 < 64) SCAN_LOAD_KV(nn + 1); }
        else {
            const int cb = w; f32x16 aI;
#pragma unroll
            for (int i = 0; i < 16; ++i) aI[i] = 0.f;
#pragma unroll
            for (int ks = 0; ks < 8; ++ks) { const bf16x8 A = *(const LAS bf16x8*)(ST + r * KP + (16 * ks + 8 * hh) * 2); aI = MFMA32(A, __builtin_bit_cast(bf16x8, pre[ks]), aI); if ((ks & 3) == 3) __builtin_amdgcn_sched_barrier(0); }
            { const bf16* pp_ = PB + (size_t)(bh * 64 + nn) * 16384 + (w * 4) * 1024;
#pragma unroll
              for (int sb = 0; sb < 4; ++sb) if (sb <= w) { const bf16* pq_ = uniform_ptr(pp_ + sb * 1024); pre[2 * sb] = *(const v4u*)(pq_ + lane * 16); pre[2 * sb + 1] = *(const v4u*)(pq_ + lane * 16 + 8); } }
            __builtin_amdgcn_sched_barrier(0);
#pragma unroll
            for (int ks = 8; ks < 16; ++ks) { const bf16x8 A = *(const LAS bf16x8*)(ST + r * KP + (16 * ks + 8 * hh) * 2); aI = MFMA32(A, __builtin_bit_cast(bf16x8, pre[ks]), aI); if ((ks & 3) == 3) __builtin_amdgcn_sched_barrier(0); }
#pragma unroll
            for (int i = 0; i < 16; ++i) aI[i] *= gc;
#pragma unroll
            for (int sb = 0; sb < 4; ++sb) if (sb <= cb) {
#pragma unroll
                for (int s2 = 0; s2 < 2; ++s2) {
                    const LAS unsigned char* vp = VL + (32 * sb + 16 * s2 + 4 * hh + q4) * VP + (16 * blk + 4 * p4) * 2;
                    const bf16x8 A = cat8(tr_read(vp), tr_read(vp + 8 * VP)); aI = MFMA32(A, __builtin_bit_cast(bf16x8, pre[2 * sb + s2]), aI); } }
            if (nn + 1 < 64) SCAN_LOAD_QP(nn + 1);
#pragma unroll
            for (int gq = 0; gq < 4; ++gq) { u32x2v pv; pv.x = cvtpk_s(aI[4 * gq], aI[4 * gq + 1]); pv.y = cvtpk_s(aI[4 * gq + 2], aI[4 * gq + 3]);
                *(LAS u32x2v*)(YT + (32 * cb + r) * VP + (8 * gq + 4 * hh) * 2) = pv; }
        }
        {
#pragma unroll
            for (int i = 0; i < 16; ++i) st[i] *= gamma;
#pragma unroll
            for (int ks = 0; ks < 8; ++ks) {
                const LAS unsigned char* kp = KT + (16 * ks + 8 * hh + q4) * KP + (32 * w + 16 * blk + 4 * p4) * 2;
                const bf16x8 A = cat8(tr_read(kp), tr_read(kp + 4 * KP));
                const LAS unsigned char* vp = VL + (16 * ks + 8 * hh + q4) * VP + (16 * blk + 4 * p4) * 2;
                const bf16x8 B0 = cat8(tr_read(vp), tr_read(vp + 4 * VP));
                st = MFMA32(A, B0, st); if (ks & 1) __builtin_amdgcn_sched_barrier(0); }
        }
        __syncthreads();
    }
    { const v4u yv = *(const LAS v4u*)(YT + (tid >> 2) * VP + (tid & 3) * 16);
      bf16* yb = YR + (size_t)(b * T + 128 * 63) * 2048 + h * 512 + 32 * es; *(v4u*)(yb + yoff) = yv; }
#undef SCAN_LOAD_KV
#undef SCAN_LOAD_QP
}

__device__ __forceinline__ void gnstats_phase(Frame& F0) {
    Frame F = F0; F.tid = opaque((int)threadIdx.x); F.lane = F.tid & 63; F.wave = __builtin_amdgcn_readfirstlane(F.tid >> 6);
    const bf16* YR = (const bf16*)(F.ws + WS_YR); f32x2v* GS = (f32x2v*)(F.ws + WS_GS);
    for (int k2 = 0; k2 < 32; ++k2) { const int it = (2048 * F.xcc + F.tk * 8 + F.wave + 256 * (k2 >> 2)) * 4 + (k2 & 3);
        const v4u yv = *(const v4u*)(YR + (size_t)it * 512 + F.lane * 8); float y[8]; unpack8(yv, y);
        float s = 0.f, q = 0.f;
#pragma unroll
        for (int i = 0; i < 8; ++i) { s += y[i]; q += y[i] * y[i]; }
        s = wave_sum(s); q = wave_sum(q);
        const float mean = s * (1.f / 512.f); float var = q * (1.f / 512.f) - mean * mean; var = var < 0.f ? 0.f : var;
        if (F.lane == 0) GS[it] = (f32x2v){mean, 1.f / sqrtf(var + GN_EPS)};
    }
}

__device__ __forceinline__ void sb_phase(Frame& F0) {
    Frame F = F0; F.tid = opaque((int)threadIdx.x); F.lane = F.tid & 63; F.wave = __builtin_amdgcn_readfirstlane(F.tid >> 6);
    const bf16* SQ = (const bf16*)(F.ws + WS_RQ); const bf16* SK = (const bf16*)F.out; const bf16* SV = (const bf16*)F.out + (size_t)M * DM; bf16* YS = (bf16*)(F.ws + WS_RQ); const bf16* MKV = (const bf16*)(F.ws + WS_MKV);
    constexpr int P = 144;
    LAS unsigned char* KL = F.lds; LAS unsigned char* VL = F.lds + 64 * P; LAS int* flags = (LAS int*)(F.lds + 2 * 64 * P);
    const int w = F.wave, lane = F.lane, r = lane & 31, hh = lane >> 5, tid = F.tid;
    const int i16 = lane & 15, q4 = i16 >> 2, p4 = i16 & 3, bk = (lane >> 4) & 1;
    const int row_l = tid >> 3, ch = tid & 7;
    for (int li = 0; li < 4; ++li) { const int lu = F.tk + 32 * li;
        const int h = lu & 15, b = F.xcc >> 2, qb = 8 * (F.xcc & 3) + (lu >> 4);
        const int t0w = 256 * qb + 32 * w;
        const bf16* qp = SQ + (size_t)(b * T + t0w + r) * DM + h * 64 + 8 * hh;
        bf16x8 qf[4];
#pragma unroll
        for (int d0 = 0; d0 < 4; ++d0) qf[d0] = *(const bf16x8*)(qp + 16 * d0);
        const int pq = NMETA + t0w + r;
        const int jtw = (t0w + 46) >> 6, jtop = (256 * qb + 224 + 46) >> 6;
        float run = 1.f; f32x16 o0, o1;
#pragma unroll
        for (int i = 0; i < 16; ++i) { o0[i] = 0.f; o1[i] = 0.f; }
        bool done = false;
        v4u kreg, vreg;
#define SB_LOAD(j_) do { int p_ = 64 * (j_) + row_l; p_ = p_ < LK ? p_ : LK - 1; const int hc_ = h * 64 + ch * 8; \
        const bf16* kp_ = p_ < NMETA ? MKV + (size_t)p_ * DM + hc_ : SK + (size_t)(b * T + p_ - NMETA) * DM + hc_; const bf16* vp_ = p_ < NMETA ? MKV + (size_t)(16 + p_) * DM + hc_ : SV + (size_t)(b * T + p_ - NMETA) * DM + hc_; \
        kreg = *(const v4u*)kp_; vreg = *(const v4u*)vp_; } while (0)
        SB_LOAD(jtop);
        for (int j = jtop; j >= 0; --j) {
            *(LAS v4u*)(KL + row_l * P + ch * 16) = kreg; *(LAS v4u*)(VL + row_l * P + ch * 16) = vreg;
            __syncthreads();
            if (j > 0) SB_LOAD(j - 1);
            if (!done && j <= jtw) {
                f32x16 p0, p1;
#pragma unroll
                for (int i = 0; i < 16; ++i) { p0[i] = 0.f; p1[i] = 0.f; }
#pragma unroll
                for (int d0 = 0; d0 < 4; ++d0) { const bf16x8 a0 = *(const LAS bf16x8*)(KL + r * P + (16 * d0 + 8 * hh) * 2); const bf16x8 a1 = *(const LAS bf16x8*)(KL + (32 + r) * P + (16 * d0 + 8 * hh) * 2);
                    p0 = MFMA32(a0, qf[d0], p0); p1 = MFMA32(a1, qf[d0], p1); }
                const bool need_mask = (64 * j + 63 >= NMETA + t0w);
#pragma unroll
                for (int bb = 1; bb >= 0; --bb) {
                    float ri[16], a[16];
#pragma unroll
                    for (int i = 0; i < 16; ++i) { const float zz = bb ? p1[i] : p0[i]; const int key = 64 * j + 32 * bb + crow(i, hh);
                        float e = __builtin_amdgcn_exp2f(fminf(zz, 126.f)); if (need_mask && key >= pq) e = 0.f;
                        ri[i] = __builtin_amdgcn_rcpf(1.f + e); a[i] = e * ri[i]; }
#pragma unroll
                    for (int gq = 3; gq >= 0; --gq) {
                        const float Gp = (ri[4 * gq] * ri[4 * gq + 1]) * (ri[4 * gq + 2] * ri[4 * gq + 3]); const float other = __shfl_xor(Gp, 32);
                        float t = hh == 0 ? run * other : run;
                        a[4 * gq + 3] *= t; t *= ri[4 * gq + 3]; a[4 * gq + 2] *= t; t *= ri[4 * gq + 2]; a[4 * gq + 1] *= t; t *= ri[4 * gq + 1]; a[4 * gq] *= t;
                        run = run * (Gp * other); }
#pragma unroll
                    for (int s = 0; s < 2; ++s) {
                        v4u pw; pw.x = cvtpk_s(a[8 * s], a[8 * s + 1]); pw.y = cvtpk_s(a[8 * s + 2], a[8 * s + 3]); pw.z = cvtpk_s(a[8 * s + 4], a[8 * s + 5]); pw.w = cvtpk_s(a[8 * s + 6], a[8 * s + 7]);
                        const bf16x8 A = __builtin_bit_cast(bf16x8, pw);
                        const LAS unsigned char* vp = VL + (32 * bb + 16 * s + 4 * hh + q4) * P + (16 * bk + 4 * p4) * 2;
                        const bf16x8 B0 = cat8(tr_read(vp), tr_read(vp + 8 * P)); const bf16x8 B1 = cat8(tr_read(vp + 64), tr_read(vp + 64 + 8 * P));
                        o0 = MFMA32(A, B0, o0); o1 = MFMA32(A, B1, o1); }
                }
                done = __all(run < 7.8886090522101181e-31f) != 0;
            }
            if (lane == 0) flags[w] = done ? 1 : 0;
            __syncthreads();
            bool all = true;
#pragma unroll
            for (int k = 0; k < 8; ++k) all = all && (flags[k] != 0);
            if (all) break;
        }
#undef SB_LOAD
        bf16* op = YS + (size_t)(b * T + t0w) * DM + h * 64 + r;
#pragma unroll
        for (int i = 0; i < 16; ++i) { bf16* rp = op + (size_t)crow(i, hh) * DM; rp[0] = (bf16)f2bf(o0[i]); rp[32] = (bf16)f2bf(o1[i]); }
    }
}

__device__ __forceinline__ void p7b_phase(Frame& F0) {
    Frame F = F0; F.tid = opaque((int)threadIdx.x); F.lane = F.tid & 63; F.wave = __builtin_amdgcn_readfirstlane(F.tid >> 6);
    bf16* HN2 = (bf16*)(F.ws + WS_HN2);
    for (int k = 0; k < 8; ++k) { const int m = 2048 * F.xcc + F.tk * 8 + F.wave + 256 * k;
        GAS f32x4* mr = (GAS f32x4*)(F.out + (size_t)m * DM) + F.lane; const GAS f32x4* mi = (const GAS f32x4*)((const float*)(F.ws + WS_FF) + (size_t)m * DM) + F.lane; const GAS f32x4* xr = (const GAS f32x4*)(F.x + (size_t)m * DM) + F.lane;
        const GAS f32x4* g1 = (const GAS f32x4*)F.g_post + F.lane; const GAS f32x4* g2 = (const GAS f32x4*)F.g_fpre + F.lane;
        f32x4 v[4]; float s = 0.f;
#pragma unroll
        for (int j = 0; j < 4; ++j) { v[j] = mr[64 * j]; s += (v[j].x * v[j].x + v[j].y * v[j].y) + (v[j].z * v[j].z + v[j].w * v[j].w); }
        const float rs = 1.f / sqrtf(wave_sum(s) * (1.f / DM) + NORM_EPS); float s2 = 0.f;
#pragma unroll
        for (int j = 0; j < 4; ++j) { v[j] = xr[64 * j] + v[j] * rs * g1[64 * j]; mr[64 * j] = v[j]; s2 += (v[j].x * v[j].x + v[j].y * v[j].y) + (v[j].z * v[j].z + v[j].w * v[j].w); }
        const float rs2 = 1.f / sqrtf(wave_sum(s2) * (1.f / DM) + NORM_EPS);
        GAS unsigned long long* o8 = (GAS unsigned long long*)(HN2 + (size_t)m * DM) + F.lane;
#pragma unroll
        for (int j = 0; j < 4; ++j) { const f32x4 g = g2[64 * j]; o8[64 * j] = (unsigned long long)pk2(v[j].x * rs2 * g.x, v[j].y * rs2 * g.y) | ((unsigned long long)pk2(v[j].z * rs2 * g.z, v[j].w * rs2 * g.w) << 32); }
    }
}
__device__ __forceinline__ void p9b_phase(Frame& F0) {
    Frame F = F0; F.tid = opaque((int)threadIdx.x); F.lane = F.tid & 63; F.wave = __builtin_amdgcn_readfirstlane(F.tid >> 6);
    const float* FFb = (const float*)(F.ws + WS_FF);
    for (int k = 0; k < 8; ++k) { const int m = 2048 * F.xcc + F.tk * 8 + F.wave + 256 * k;
        GAS f32x4* hr = (GAS f32x4*)(F.out + (size_t)m * DM) + F.lane; const GAS f32x4* fr = (const GAS f32x4*)(FFb + (size_t)m * DM) + F.lane;
        const GAS f32x4* g3 = (const GAS f32x4*)F.g_fpost + F.lane;
        f32x4 v[4]; float s = 0.f;
#pragma unroll
        for (int j = 0; j < 4; ++j) { v[j] = fr[64 * j]; s += (v[j].x * v[j].x + v[j].y * v[j].y) + (v[j].z * v[j].z + v[j].w * v[j].w); }
        const float rs = 1.f / sqrtf(wave_sum(s) * (1.f / DM) + NORM_EPS);
#pragma unroll
        for (int j = 0; j < 4; ++j) hr[64 * j] = hr[64 * j] + v[j] * rs * g3[64 * j];
    }
}


#ifndef DEBUG_STOP
#define DEBUG_STOP 0
#endif
#ifndef DEBUG_CMODE
#define DEBUG_CMODE 0
#endif
__device__ __forceinline__ void dbg_dump(Frame& F, const bf16* b0, int ld0, const bf16* b1, int ld1, const bf16* b2, int ld2, const bf16* b3, int ld3) {
    const int tid = threadIdx.x;
    for (int e0 = F.tk * 512 + tid; e0 < 2048 * DM; e0 += 32 * 512) { const int m = 2048 * F.xcc + (e0 >> 10), c = e0 & 1023; const size_t e = (size_t)m * DM + c; float v = 0.f;
#ifndef DEBUG_CLAMP
#define DEBUG_CLAMP 1e30f
#endif
#define DCL(x) fminf(fmaxf((x), -DEBUG_CLAMP), DEBUG_CLAMP)
        if (b0) v += DCL(bf2f(b0[(size_t)m * ld0 + c])); if (b1) v += DCL(bf2f(b1[(size_t)m * ld1 + c])); if (b2) v += DCL(bf2f(b2[(size_t)m * ld2 + c])); if (b3) v += DCL(bf2f(b3[(size_t)m * ld3 + c]));
        F.out[e] = v; }
}

__device__ __forceinline__ void dbg_maxloc(Frame& F, XcdBarrier& bar, const bf16* buf, int ld, int ncols) {
    gu32* slot = F.ctl + 2048;
    const int tid = threadIdx.x; const int gt = F.vcu * 512 + tid, NGT = F.G * 512; float mx = 0.f; int mrow = 0;
#if defined(DEBUG_SC1)
    for (size_t e = gt; e < (size_t)M * ncols / 2; e += NGT) { const int m = (int)(e / (ncols / 2)), c = 2 * (int)(e % (ncols / 2)); const unsigned w2 = __hip_atomic_load((const unsigned*)(buf + (size_t)m * ld + c), __ATOMIC_RELAXED, __HIP_MEMORY_SCOPE_SYSTEM);
        const float v = fmaxf(fabsf(__uint_as_float(w2 << 16)), fabsf(__uint_as_float(w2 & 0xffff0000u))); if (v > mx) { mx = v; mrow = m; } }
#else
    for (int e0 = F.tk * 512 + tid; e0 < 2048 * ncols; e0 += 32 * 512) { const int m = 2048 * F.xcc + e0 / ncols, c = e0 % ncols; const float v = fabsf(bf2f(buf[(size_t)m * ld + c])); if (v > mx) { mx = v; mrow = m; } }
#endif
    atomicMax((unsigned*)slot, __float_as_uint(mx));
    xcd_barrier(bar);
    const unsigned gm = __hip_atomic_load(slot, __ATOMIC_RELAXED, __HIP_MEMORY_SCOPE_AGENT);
    if (__float_as_uint(mx) == gm && gm != 0u) __hip_atomic_store(slot + 1, (unsigned)mrow, __ATOMIC_RELAXED, __HIP_MEMORY_SCOPE_AGENT);
    xcd_barrier(bar);
    const float gmax = __uint_as_float(gm); const float grow = (float)__hip_atomic_load(slot + 1, __ATOMIC_RELAXED, __HIP_MEMORY_SCOPE_AGENT);
#ifndef DEBUG_ROWDIV
#define DEBUG_ROWDIV 16.0f
#endif
#if defined(DEBUG_ROWMODE)
    const float k1 = 10.f * grow, k2 = k1;
#else
    const float k1 = 100.f * gmax, k2 = k1;
#endif
    for (size_t e = gt; e < (size_t)M * DM; e += NGT) F.out[e] = (e < (size_t)M * DM / 2) ? k1 : k2;
}

__device__ __forceinline__ void dbg_check_gate(Frame& F, XcdBarrier& bar, const bf16* XN, const bf16* W, const bf16* G, int mode, int ldg = DM, bool ident = false) {
    gu32* slot = F.ctl + 2048;
    const int tid = threadIdx.x; unsigned cnt = 0u; unsigned best = 0u; unsigned bcol = 0u;
    for (int e0 = F.tk * 512 + tid; e0 < 2048 * 16; e0 += 32 * 512) { const int m = 2048 * F.xcc + (e0 >> 4), c = (e0 & 15) * 64 + ((e0 >> 4) & 63);
        float acc = 0.f; const bf16* xr = XN + (size_t)m * DM; const bf16* wr = W + (size_t)c * DM;
        for (int k = 0; k < DM; ++k) acc += bf2f(xr[k]) * bf2f(wr[k]);
        const float ref = ident ? acc : 1.f / (1.f + expf(-acc)); const float got = bf2f(G[(size_t)m * ldg + c]);
        if (!(fabsf(got - ref) < 0.02f + 0.01f * fabsf(ref))) { ++cnt; const unsigned key = 0x7fffffffu - (unsigned)m; if (key > best) { best = key; bcol = (unsigned)c; } } }
    atomicAdd((unsigned*)slot, cnt); atomicMax((unsigned*)slot + 1, best);
    xcd_barrier(bar);
    const unsigned gb = __hip_atomic_load(slot + 1, RLX_AGENT);
    if (best == gb && gb != 0u) __hip_atomic_store(slot + 2, bcol, RLX_AGENT);
    xcd_barrier(bar);
    const float total = (float)__hip_atomic_load(slot, RLX_AGENT); const float minrow = gb ? (float)(0x7fffffffu - gb) : -1.f; const float col = (float)__hip_atomic_load(slot + 2, RLX_AGENT);
    float bucket = 0.f; { float t = total; while (t >= 1.f) { bucket += 1.f; t *= 0.0625f; } }
    const float k = mode == 0 ? 1000.f * bucket : (mode == 1 ? 10.f * (minrow + 1.f) : 100.f * (col + 1.f));
    for (size_t e = (size_t)blockIdx.x * 512 + tid; e < (size_t)M * DM; e += (size_t)gridDim.x * 512) F.out[e] = k;
}

__device__ __forceinline__ void dbg_check_w(Frame& F, XcdBarrier& bar, const bf16* WT, int row0, int orig0, int nrows) {
    gu32* slot = F.ctl + 2048; const int tid = threadIdx.x; unsigned cnt = 0u;
    for (int e = F.vcu * 512 + tid; e < nrows * 64; e += F.G * 512) { const int r = e >> 6, k = ((e & 63) * 16 + (r & 15)) & 1023;
        const unsigned want = f2bf(F.w_in[(size_t)k * PW + orig0 + r]); const unsigned got = WT[(size_t)(row0 + r) * DM + k];
        if (want != got) ++cnt; }
    atomicAdd((unsigned*)slot, cnt);
    xcd_barrier(bar);
    const float total = (float)__hip_atomic_load(slot, RLX_AGENT);
    float bucket = 0.f; { float t = total; while (t >= 1.f) { bucket += 1.f; t *= 0.0625f; } }
    const float k = 1000.f * bucket;
    for (size_t e = (size_t)blockIdx.x * 512 + tid; e < (size_t)M * DM; e += (size_t)gridDim.x * 512) F.out[e] = k;
}
struct Args { const float* in[12]; float* out; unsigned char* ws; };
#ifndef PHM
#define PHM 0xFFFFF
#endif
#define PH(k) ((PHM >> (k)) & 1)
#ifndef PG8_SP2
#define PG8_SP2 true
#endif
#ifndef PG8_ALIGN
#define PG8_ALIGN true
#endif
__global__ void __launch_bounds__(NWAVES * 64, 2) mk_fwd(Args args) {
    extern __shared__ __attribute__((aligned(16))) unsigned char lds[];
    Frame F;
    F.lds = (LAS unsigned char*)lds;
    F.MISC = (volatile LAS unsigned*)(F.lds + MISC_OFF);
    F.tid = 0; F.lane = 0; F.wave = 0;
    F.G = gridDim.x; { const int bx = blockIdx.x; F.vcu = (F.G % 8 == 0) ? (bx % 8) * (F.G / 8) + bx / 8 : bx; }
    unsigned char* ws = args.ws; F.ws = ws;
    F.ctl = (gu32*)(ws + WS_CTL);
    F.x = args.in[0]; F.meta = args.in[1]; F.w_in = args.in[2]; F.w_ro = args.in[3]; F.w_so = args.in[4]; F.w_out = args.in[5]; F.w_fi = args.in[6]; F.w_fo = args.in[7];
    F.g_pre = args.in[8]; F.g_post = args.in[9]; F.g_fpre = args.in[10]; F.g_fpost = args.in[11]; F.out = args.out;
    for (int u = threadIdx.x; u < (LDS_BYTES - LDSCTL_OFF) / 4; u += NWAVES * 64) ((LAS unsigned*)(F.lds + LDSCTL_OFF))[u] = 0u;
    __syncthreads();
    XcdBarrier bar = xcd_barrier_post((unsigned*)(F.ctl + CW_BAR), F.MISC + 8);
    if (threadIdx.x == 0) { const unsigned x = xb_xcc_id() & 7u; const unsigned t = __hip_atomic_fetch_add(F.ctl + CW_TICKET + 64 * x, 1u, RLX_AGENT);
        if (t >= 32u) __hip_atomic_store(F.ctl + CW_BAD, 1u, RLX_AGENT);
        F.MISC[16] = x; F.MISC[17] = t & 31u; }
    __syncthreads();
    F.xcc = __builtin_amdgcn_readfirstlane((int)F.MISC[16]); F.tk = __builtin_amdgcn_readfirstlane((int)F.MISC[17]); F.cg = F.tk * 8 + F.xcc; F.vcu = F.xcc * 32 + F.tk;
#if defined(DEBUG_TIME)
    int n_stamp = 0;
#define GRID_BAR() do { xcd_barrier(bar); if (blockIdx.x == 0 && threadIdx.x == 0) { const unsigned long long t_ = __builtin_amdgcn_s_memrealtime(); __hip_atomic_store(F.ctl + 3000 + 2 * n_stamp, (unsigned)t_, RLX_AGENT); } ++n_stamp; } while (0)
#else
#define GRID_BAR() xcd_barrier(bar)
#endif
    bf16* WIN = (bf16*)(ws + WS_WIN); bf16* XN = (bf16*)(ws + WS_XN);

    if (DEBUG_STOP == 20) {
        GRID_BAR();
        unsigned mx = 0u, npop = 0u;
        for (int x = 0; x < 8; ++x) { const unsigned c = __hip_atomic_load(F.ctl + CW_TICKET + 64 * x, RLX_AGENT); mx = c > mx ? c : mx; npop += c > 0u ? 1u : 0u; }
        const float k1 = 1000.f * (float)mx, k2 = 100.f * (float)npop;
        for (size_t e = (size_t)blockIdx.x * 512 + threadIdx.x; e < (size_t)M * DM; e += (size_t)gridDim.x * 512) F.out[e] = (e < (size_t)M * DM / 2) ? k1 : k2;
        return;
    }
#if defined(DEBUG_FILL)
    {
        const size_t n16 = (WS_END - CTL_ZERO_BYTES) / 16; v4u* p16 = (v4u*)(ws + CTL_ZERO_BYTES); const v4u z = {DEBUG_FILL, DEBUG_FILL, DEBUG_FILL, DEBUG_FILL};
        for (size_t i = (size_t)blockIdx.x * 512 + threadIdx.x; i < n16; i += (size_t)gridDim.x * 512) p16[i] = z;
        GRID_BAR();
    }
#endif
    if (PH(0)) p0_prologue(F); GRID_BAR();
    if (PH(1)) { pg8::Gemm g{XN, WIN, M, 4096, DM}; pg8::StaticOrder S; S.init(M, 4096, F.G, F.cg);
      EpiP1 E{(bf16*)(ws + WS_RQ), (bf16*)(ws + WS_RK), (bf16*)(ws + WS_YR)};
      pg8::gemm_phase<EpiP1, pg8::StaticOrder, PG8_ALIGN, PG8_SP2>(F.lds, g, S, E); }
    GRID_BAR();
    if (DEBUG_STOP == 54) { dbg_check_w(F, bar, WIN, 9216, 9216, 2048); return; }
    if (DEBUG_STOP == 55) { dbg_check_w(F, bar, WIN, 0, 0, 4096); return; }
    if (DEBUG_STOP == 53) {
        { pg8::Gemm g{XN, WIN + (size_t)9216 * DM, M, 2048, DM}; pg8::StaticOrder S; S.init(M, 2048, F.G, F.cg);
          EpiSig E{(bf16*)(ws + WS_GB), (bf16*)(ws + WS_GA)};
          pg8::gemm_phase<EpiSig, pg8::StaticOrder, PG8_ALIGN, PG8_SP2>(F.lds, g, S, E); }
        GRID_BAR();
#if defined(DEBUG_SIGID)
        dbg_check_gate(F, bar, XN, WIN + (size_t)9216 * DM, (const bf16*)(ws + WS_GB), DEBUG_CMODE, DM, true); return; }
#else
        dbg_check_gate(F, bar, XN, WIN + (size_t)9216 * DM, (const bf16*)(ws + WS_GB), DEBUG_CMODE); return; }
#endif
    if (DEBUG_STOP == 52) { dbg_check_gate(F, bar, XN, WIN + (size_t)2048 * DM, (const bf16*)(ws + WS_YR), DEBUG_CMODE, 2048, true); return; }
    if (DEBUG_STOP == 1) { dbg_dump(F, (const bf16*)(ws + WS_RQ), DM, (const bf16*)(ws + WS_RK), DM, (const bf16*)(ws + WS_YR), 2048, (const bf16*)(ws + WS_YR) + 1024, 2048); return; }
    if (PH(2)) scores_phase(F); GRID_BAR();
    if (DEBUG_STOP == 8) { dbg_dump(F, (const bf16*)(ws + WS_PB), 512, nullptr, 0, nullptr, 0, nullptr, 0); return; }
    if (PH(3)) scan_phase(F); GRID_BAR();
    if (DEBUG_STOP == 12) { dbg_maxloc(F, bar, (const bf16*)(ws + WS_YR), 2048, 2048); return; }
    if (DEBUG_STOP == 2) { dbg_dump(F, (const bf16*)(ws + WS_YR), 2048, (const bf16*)(ws + WS_YR) + 1024, 2048, nullptr, 0, nullptr, 0); return; }
    if (PH(4)) gnstats_phase(F);
    if (PH(5)) { pg8::Gemm g{XN, WIN + (size_t)4096 * DM, M, 3072, DM}; pg8::StaticOrder S; S.init(M, 3072, F.G, F.cg);
      EpiP3 E{(bf16*)(ws + WS_RQ), (bf16*)F.out, (bf16*)F.out + (size_t)M * DM};
      pg8::gemm_phase<EpiP3, pg8::StaticOrder, PG8_ALIGN, PG8_SP2>(F.lds, g, S, E); }
    GRID_BAR();
    if (PH(6)) sb_phase(F); GRID_BAR();
    if (DEBUG_STOP == 3) { dbg_dump(F, (const bf16*)(ws + WS_RQ), DM, nullptr, 0, nullptr, 0, nullptr, 0); return; }
    if (PH(7)) { pg8::Gemm g{XN, WIN + (size_t)7168 * DM, M, 2048, DM}; pg8::StaticOrder S; S.init(M, 2048, F.G, F.cg);
      EpiRG E{(bf16*)(ws + WS_YR), (const f32x2v*)(ws + WS_GS)};
      pg8::gemm_phase<EpiRG, pg8::StaticOrder, PG8_ALIGN, PG8_SP2>(F.lds, g, S, E); }
    if (PH(7)) { pg8::Gemm g{XN, WIN + (size_t)9216 * DM, M, 2048, DM}; pg8::StaticOrder S; S.init(M, 2048, F.G, F.cg);
      EpiSig E{(bf16*)(ws + WS_GA), (bf16*)(ws + WS_GB)};
      pg8::gemm_phase<EpiSig, pg8::StaticOrder, PG8_ALIGN, PG8_SP2>(F.lds, g, S, E); }
    GRID_BAR();
    if (DEBUG_STOP == 14) { dbg_maxloc(F, bar, (const bf16*)(ws + WS_YR), 2048, 2048); return; }
    if (DEBUG_STOP == 15) { dbg_maxloc(F, bar, (const bf16*)(ws + WS_GA), DM, DM); return; }
    if (DEBUG_STOP == 16) { dbg_maxloc(F, bar, (const bf16*)(ws + WS_GB), DM, DM); return; }
    if (DEBUG_STOP == 50) { dbg_check_gate(F, bar, XN, WIN + (size_t)9216 * DM, (const bf16*)(ws + WS_GA), DEBUG_CMODE); return; }
    if (DEBUG_STOP == 51) { dbg_check_gate(F, bar, XN, WIN + (size_t)10240 * DM, (const bf16*)(ws + WS_GB), DEBUG_CMODE); return; }
    if (DEBUG_STOP == 43) { dbg_dump(F, (const bf16*)(ws + WS_GA), DM, nullptr, 0, nullptr, 0, nullptr, 0); return; }
    if (DEBUG_STOP == 44) { dbg_dump(F, (const bf16*)(ws + WS_GB), DM, nullptr, 0, nullptr, 0, nullptr, 0); return; }
    if (DEBUG_STOP == 41) { dbg_dump(F, (const bf16*)(ws + WS_GA), DM, (const bf16*)(ws + WS_GB), DM, nullptr, 0, nullptr, 0); return; }
    if (DEBUG_STOP == 42) { dbg_dump(F, (const bf16*)(ws + WS_YR), 2048, (const bf16*)(ws + WS_YR) + 1024, 2048, nullptr, 0, nullptr, 0); return; }
    if (DEBUG_STOP == 4) { dbg_dump(F, (const bf16*)(ws + WS_GA), DM, (const bf16*)(ws + WS_GB), DM, (const bf16*)(ws + WS_YR), 2048, (const bf16*)(ws + WS_YR) + 1024, 2048); return; }
    if (PH(8)) { pg8::Gemm g{(const bf16*)(ws + WS_YR), (const bf16*)(ws + WS_WRO), M, DM, 2048}; pg8::StaticOrder S; S.init(M, DM, F.G, F.cg);
      EpiP6<false> E{(bf16*)(ws + WS_MG), (const bf16*)(ws + WS_GA)};
      pg8::gemm_phase<EpiP6<false>, pg8::StaticOrder, PG8_ALIGN, PG8_SP2>(F.lds, g, S, E); }
    if (PH(9)) { pg8::Gemm g{(const bf16*)(ws + WS_RQ), (const bf16*)(ws + WS_WSO), M, DM, DM}; pg8::StaticOrder S; S.init(M, DM, F.G, F.cg);
      EpiP6<true> E{(bf16*)(ws + WS_MG), (const bf16*)(ws + WS_GB)};
      pg8::gemm_phase<EpiP6<true>, pg8::StaticOrder, PG8_ALIGN, PG8_SP2>(F.lds, g, S, E); }
    GRID_BAR();
    if (DEBUG_STOP == 5) { dbg_dump(F, (const bf16*)(ws + WS_MG), DM, nullptr, 0, nullptr, 0, nullptr, 0); return; }
#if defined(DEBUG_COPYMG)
    {
        const v4u* src = (const v4u*)(ws + WS_MG); v4u* dst = (v4u*)(ws + WS_RQ); const size_t n16 = (size_t)M * DM * 2 / 16;
        for (size_t i = (size_t)blockIdx.x * 512 + threadIdx.x; i < n16; i += (size_t)gridDim.x * 512) dst[i] = src[i];
        GRID_BAR();
    }
#define DEBUG_P7A WS_RQ
#endif
#ifndef DEBUG_P7A
#define DEBUG_P7A WS_MG
#endif
    if (PH(10)) { pg8::Gemm g{(const bf16*)(ws + DEBUG_P7A), (const bf16*)(ws + WS_WOUT), M, DM, DM}; pg8::StaticOrder S; S.init(M, DM, F.G, F.cg);
      EpiF32 E{F.out, DM};
      pg8::gemm_phase<EpiF32, pg8::StaticOrder, PG8_ALIGN, PG8_SP2>(F.lds, g, S, E); }
    GRID_BAR();
    if (DEBUG_STOP == 7) return;
    if (PH(11)) p7b_phase(F); GRID_BAR();
    if (DEBUG_STOP == 6) return;
    if (PH(12)) { pg8::Gemm g{(const bf16*)(ws + WS_HN2), (const bf16*)(ws + WS_WFI), M, 2 * DFF, DM}; pg8::StaticOrder S; S.init(M, 2 * DFF, F.G, F.cg);
      EpiP8 E{(bf16*)(ws + WS_ACT)};
      pg8::gemm_phase<EpiP8, pg8::StaticOrder, PG8_ALIGN, PG8_SP2>(F.lds, g, S, E); }
    GRID_BAR();
    if (PH(13)) { pg8::Gemm g{(const bf16*)(ws + WS_ACT), (const bf16*)(ws + WS_WFO), M, DM, DFF}; pg8::StaticOrder S; S.init(M, DM, F.G, F.cg);
      EpiF32 E{(float*)(ws + WS_FF), DM};
      pg8::gemm_phase<EpiF32, pg8::StaticOrder, PG8_ALIGN, PG8_SP2>(F.lds, g, S, E); }
    GRID_BAR();
    if (PH(14)) p9b_phase(F);
#if defined(DEBUG_TIME)
    GRID_BAR();
    {
        const unsigned a = __hip_atomic_load(F.ctl + 3000 + 2 * (DEBUG_TIME - 1), RLX_AGENT), b2 = __hip_atomic_load(F.ctl + 3000 + 2 * (DEBUG_TIME), RLX_AGENT);
        const float k = (float)(b2 - a);
        for (size_t e = (size_t)blockIdx.x * 512 + threadIdx.x; e < (size_t)M * DM; e += (size_t)gridDim.x * 512) F.out[e] = k;
        return;
    }
#endif
    if (xb_ld(&bar.bar[XB_TMO]) != 0u || __hip_atomic_load(F.ctl + CW_BAD, RLX_AGENT) != 0u) {
        const int tid = threadIdx.x, lane = tid & 63, wave = tid >> 6; const float qn = __builtin_nanf("");
        for (int k = 0; k < 8; ++k) { const int m = 2048 * F.xcc + F.tk * 8 + wave + 256 * k; GAS f32x4* o = (GAS f32x4*)(F.out + (size_t)m * DM) + lane;
#pragma unroll
            for (int j = 0; j < 4; ++j) o[64 * j] = (f32x4){qn, qn, qn, qn}; }
    }
#undef GRID_BAR
}

extern "C" void kernel_launch(void* const* d_in, const int* in_sizes, int n_in, void* d_out, int out_size, void* d_ws, size_t ws_size, hipStream_t stream) {
    static int grid = 0;
    if (grid == 0) {
        if (n_in != 12 || in_sizes[0] != M * DM || out_size != M * DM || ws_size < WS_END) { fprintf(stderr, "kernel_launch: unexpected shapes (n_in %d, in0 %d, out %d, ws %zu); nothing launched\n", n_in, n_in > 0 ? in_sizes[0] : -1, out_size, ws_size); grid = -1; return; }
        int dev = 0, cus = 0, per_cu = 0;
        if (hipGetDevice(&dev) != hipSuccess || hipDeviceGetAttribute(&cus, hipDeviceAttributeMultiprocessorCount, dev) != hipSuccess) { grid = -1; return; }
        if (hipFuncSetAttribute((const void*)mk_fwd, hipFuncAttributeMaxDynamicSharedMemorySize, LDS_BYTES) != hipSuccess) { fprintf(stderr, "kernel_launch: hipFuncSetAttribute failed\n"); grid = -1; return; }
        if (hipOccupancyMaxActiveBlocksPerMultiprocessor(&per_cu, (const void*)mk_fwd, NWAVES * 64, LDS_BYTES) != hipSuccess || per_cu < 1) fprintf(stderr, "kernel_launch: occupancy query reports %d\n", per_cu);
        (void)hipGetLastError();
        grid = cus;
        if (grid != 256) { fprintf(stderr, "kernel_launch: built for a 256-CU device, found %d CUs; nothing launched\n", cus); grid = -1; return; }
    }
    if (grid < 0) return;
    if (hipMemsetAsync((char*)d_ws + WS_CTL, 0, CTL_ZERO_BYTES, stream) != hipSuccess) return;
    Args a{};
    for (int i = 0; i < 12; ++i) a.in[i] = (const float*)d_in[i];
    a.out = (float*)d_out; a.ws = (unsigned char*)d_ws;
    hipLaunchKernelGGL(mk_fwd, dim3(grid), dim3(NWAVES * 64), LDS_BYTES, stream, a);
}
```
